# Optimizing an MI355X kernel written in HIP

```python
import math
import jax, jax.numpy as jnp
from jax import lax
import numpy as np

D_MODEL = 1024
BATCH = 2
SEQ = 8192
DEPTH = 2

HEAD_DIM = 64
N_HEADS_DIFF = 4
N_HEADS_DIL = 6
N_HEADS_MOBA = 6
N_HEADS_MIX = N_HEADS_DIFF + N_HEADS_DIL + N_HEADS_MOBA
MIX_WIDTH = N_HEADS_MIX * HEAD_DIM
DIFF_HALF = HEAD_DIM // 2
ROPE_THETA = 500000.0
ROPE_FRACTION = 4
DILATED_PAIRS = ((128, 1), (512, 4), (2048, 16))
MOBA_BLOCK = 256
MOBA_TOPK = 3
MOBA_Q_CHUNK = 64
Q_BLOCK = 128
MEM_LEN = 256
N_HEADS_MEM = 4
MEM_WIDTH = N_HEADS_MEM * HEAD_DIM
D_FF = -(-(8 * D_MODEL) // (3 * 256)) * 256
EPS = 1e-6

kernel_name = "hymba_style_diff_dilated_moba_hybrid"


def rms_norm(x, w):
    xf = x.astype(jnp.float32)
    y = xf * lax.rsqrt(jnp.mean(xf * xf, axis=-1, keepdims=True) + EPS)
    return (y * w.astype(jnp.float32)).astype(x.dtype)


def rotary(x, positions, rot_dim):
    half = rot_dim // 2
    inv_freq = ROPE_THETA ** (-jnp.arange(half, dtype=jnp.float32) / half)
    ang = positions.astype(jnp.float32)[..., None] * inv_freq
    cos = jnp.cos(ang)[:, :, None, :]
    sin = jnp.sin(ang)[:, :, None, :]
    xr = x[..., :rot_dim].astype(jnp.float32)
    x1, x2 = xr[..., :half], xr[..., half:]
    rot = jnp.concatenate([x1 * cos - x2 * sin, x2 * cos + x1 * sin], axis=-1).astype(x.dtype)
    return jnp.concatenate([rot, x[..., rot_dim:]], axis=-1)


def diff_qk_prep(t, gain, positions):
    B, S, H, _ = t.shape
    t = t.reshape(B, S, 2 * H, DIFF_HALF)
    t = rotary(rms_norm(t, gain), positions, DIFF_HALF // ROPE_FRACTION)
    return t.reshape(B, S, H, 2, DIFF_HALF)


def diff_attention(q1, q2, k1, k2, v, lam):
    B, S, H, Dh = q1.shape
    scale = Dh ** -0.5
    key_idx = jnp.arange(S)

    def one_block(start):
        qs1 = lax.dynamic_slice_in_dim(q1, start, Q_BLOCK, axis=1)
        qs2 = lax.dynamic_slice_in_dim(q2, start, Q_BLOCK, axis=1)
        q_idx = start + jnp.arange(Q_BLOCK)
        mask = (key_idx[None, :] <= q_idx[:, None])[None, None]
        s1 = jnp.einsum('bqhd,bkhd->bhqk', qs1, k1, preferred_element_type=jnp.float32) * scale
        s2 = jnp.einsum('bqhd,bkhd->bhqk', qs2, k2, preferred_element_type=jnp.float32) * scale
        p1 = jax.nn.softmax(jnp.where(mask, s1, -jnp.inf), axis=-1)
        p2 = jax.nn.softmax(jnp.where(mask, s2, -jnp.inf), axis=-1)
        p = (p1 - lam * p2).astype(v.dtype)
        return jnp.einsum('bhqk,bkhd->bqhd', p, v)

    out = lax.map(one_block, jnp.arange(S // Q_BLOCK) * Q_BLOCK)
    return jnp.moveaxis(out, 0, 1).reshape(B, S, H, v.shape[-1])


def dilated_branch(q, k, v, window, dilation):
    B, S, H, D = q.shape
    W = window // dilation
    unit = dilation * W
    Sp = -(-S // unit) * unit
    nc = Sp // unit
    pad = Sp - S

    def to_blocks(t):
        t = jnp.pad(t, ((0, 0), (0, pad), (0, 0), (0, 0)))
        return t.reshape(B, nc, W, dilation, H, D)

    def with_prev(t):
        prev = jnp.pad(t, ((0, 0), (1, 0), (0, 0), (0, 0), (0, 0), (0, 0)))[:, :-1]
        return jnp.concatenate([prev, t], axis=2)

    qb = to_blocks(q)
    kw = with_prev(to_blocks(k))
    vw = with_prev(to_blocks(v))
    s = jnp.einsum('bcirhd,bcjrhd->bcrhij', qb, kw, preferred_element_type=jnp.float32) * (D ** -0.5)
    m_q = jnp.arange(nc)[:, None, None] * W + jnp.arange(W)[None, :, None]
    m_k = jnp.arange(nc)[:, None, None] * W + jnp.arange(2 * W)[None, None, :] - W
    delta = m_q - m_k
    valid = (delta >= 0) & (delta <= W) & (m_k >= 0)
    s = jnp.where(valid[None, :, None, None, :, :], s, -jnp.inf)
    lse = jax.nn.logsumexp(s, axis=-1)
    p = jnp.exp(s - lse[..., None]).astype(v.dtype)
    o = jnp.einsum('bcrhij,bcjrhd->bcirhd', p, vw).reshape(B, Sp, H, D)[:, :S]
    lse = jnp.transpose(lse, (0, 1, 4, 2, 3)).reshape(B, Sp, H)[:, :S]
    return o, lse


def dilated_mixture(q, k, v):
    outs, lses = [], []
    for window, dilation in DILATED_PAIRS:
        o, lse = dilated_branch(q, k, v, window, dilation)
        outs.append(o)
        lses.append(lse)
    w = jax.nn.softmax(jnp.stack(lses, axis=0), axis=0)
    o = jnp.sum(w[..., None] * jnp.stack(outs, axis=0).astype(jnp.float32), axis=0)
    return o.astype(v.dtype)


def moba_attention(q, k, v):
    B, S, H, D = q.shape
    scale = D ** -0.5
    Sp = -(-S // MOBA_BLOCK) * MOBA_BLOCK
    nblk = Sp // MOBA_BLOCK
    n_sel = min(MOBA_TOPK, nblk)
    pad = Sp - S
    kp = jnp.pad(k, ((0, 0), (0, pad), (0, 0), (0, 0)))
    vp = jnp.pad(v, ((0, 0), (0, pad), (0, 0), (0, 0)))
    kbt = kp.reshape(B, nblk, MOBA_BLOCK, H, D).transpose(0, 1, 3, 2, 4)
    vbt = vp.reshape(B, nblk, MOBA_BLOCK, H, D).transpose(0, 1, 3, 2, 4)
    k_mean = jnp.mean(kbt.astype(jnp.float32), axis=3)
    b_idx = jnp.arange(B)[:, None, None, None]
    h_idx = jnp.arange(H)[None, None, :, None]
    blk_ids = jnp.arange(nblk)

    def one_chunk(start):
        qs = lax.dynamic_slice_in_dim(q, start, MOBA_Q_CHUNK, axis=1)
        q_pos = start + jnp.arange(MOBA_Q_CHUNK)
        own = start // MOBA_BLOCK
        gate = jnp.einsum('bqhd,bnhd->bqhn', qs.astype(jnp.float32), k_mean)
        gate = jnp.where(blk_ids < own, gate, -jnp.inf)
        _, sel = lax.top_k(gate, n_sel)
        sel_valid = sel < own
        ks = kbt[b_idx, sel, h_idx]
        vs = vbt[b_idx, sel, h_idx]
        s_sel = jnp.einsum('bqhd,bqhnkd->bqhnk', qs, ks, preferred_element_type=jnp.float32) * scale
        s_sel = jnp.where(sel_valid[..., None], s_sel, -jnp.inf).reshape(B, MOBA_Q_CHUNK, H, n_sel * MOBA_BLOCK)
        k_own = lax.dynamic_slice_in_dim(kp, own * MOBA_BLOCK, MOBA_BLOCK, axis=1)
        v_own = lax.dynamic_slice_in_dim(vp, own * MOBA_BLOCK, MOBA_BLOCK, axis=1)
        own_pos = own * MOBA_BLOCK + jnp.arange(MOBA_BLOCK)
        s_own = jnp.einsum('bqhd,bkhd->bqhk', qs, k_own, preferred_element_type=jnp.float32) * scale
        s_own = jnp.where((own_pos[None, :] <= q_pos[:, None])[None, :, None, :], s_own, -jnp.inf)
        p = jax.nn.softmax(jnp.concatenate([s_sel, s_own], axis=-1), axis=-1).astype(v.dtype)
        p_sel = p[..., :n_sel * MOBA_BLOCK].reshape(B, MOBA_Q_CHUNK, H, n_sel, MOBA_BLOCK)
        p_own = p[..., n_sel * MOBA_BLOCK:]
        return (jnp.einsum('bqhnk,bqhnkd->bqhd', p_sel, vs)
                + jnp.einsum('bqhk,bkhd->bqhd', p_own, v_own))

    out = lax.map(one_chunk, jnp.arange(S // MOBA_Q_CHUNK) * MOBA_Q_CHUNK)
    return jnp.moveaxis(out, 0, 1).reshape(B, S, H, D)


def memory_cross_attention(h, mem_n, w_q, w_kv, w_o, q_gain, k_gain):
    B, S, _ = h.shape
    M = mem_n.shape[1]
    q = rms_norm((h @ w_q).reshape(B, S, N_HEADS_MEM, HEAD_DIM), q_gain)
    kv = (mem_n @ w_kv).reshape(B, M, 2, N_HEADS_MEM, HEAD_DIM)
    k = rms_norm(kv[:, :, 0], k_gain)
    v = kv[:, :, 1]
    s = jnp.einsum('bshd,bmhd->bhsm', q, k, preferred_element_type=jnp.float32) * (HEAD_DIM ** -0.5)
    p = jax.nn.softmax(s, axis=-1).astype(v.dtype)
    o = jnp.einsum('bhsm,bmhd->bshd', p, v).reshape(B, S, MEM_WIDTH)
    return o @ w_o


def swiglu(h, w_gate_up, w_down):
    gu = h @ w_gate_up
    g, u = gu[..., :D_FF], gu[..., D_FF:]
    return (jax.nn.silu(g) * u) @ w_down


def setup_inputs(seed: int = 0) -> dict:
    key = jax.random.key(seed)
    ks = iter(jax.random.split(key, 40))

    def nrm(shape, scale):
        return jax.random.normal(next(ks), shape, dtype=jnp.float32) * scale

    def gain(shape):
        return 1.0 + nrm(shape, 0.02)

    L = DEPTH
    return {
        "x": nrm((BATCH, SEQ, D_MODEL), 1.0),
        "mem": nrm((BATCH, MEM_LEN, D_MODEL), 1.0),
        "positions": jnp.broadcast_to(jnp.arange(SEQ, dtype=jnp.int32)[None, :], (BATCH, SEQ)),
        "norm_mix": gain((L, D_MODEL)),
        "w_in": nrm((L, D_MODEL, 3 * MIX_WIDTH), D_MODEL ** -0.5),
        "qn_diff": gain((L, DIFF_HALF)),
        "kn_diff": gain((L, DIFF_HALF)),
        "lambda_q1": nrm((L, DIFF_HALF), 0.1),
        "lambda_k1": nrm((L, DIFF_HALF), 0.1),
        "lambda_q2": nrm((L, DIFF_HALF), 0.1),
        "lambda_k2": nrm((L, DIFF_HALF), 0.1),
        "subln_diff": gain((L, HEAD_DIM)),
        "qn_dil": gain((L, HEAD_DIM)),
        "kn_dil": gain((L, HEAD_DIM)),
        "qn_moba": gain((L, HEAD_DIM)),
        "kn_moba": gain((L, HEAD_DIM)),
        "w_out": nrm((L, MIX_WIDTH, D_MODEL), MIX_WIDTH ** -0.5),
        "norm_cross": gain((L, D_MODEL)),
        "norm_mem": gain((L, D_MODEL)),
        "w_mq": nrm((L, D_MODEL, MEM_WIDTH), D_MODEL ** -0.5),
        "w_mkv": nrm((L, D_MODEL, 2 * MEM_WIDTH), D_MODEL ** -0.5),
        "qn_mem": gain((L, HEAD_DIM)),
        "kn_mem": gain((L, HEAD_DIM)),
        "w_mo": nrm((L, MEM_WIDTH, D_MODEL), MEM_WIDTH ** -0.5),
        "norm_ffn": gain((L, D_MODEL)),
        "w_gate_up": nrm((L, D_MODEL, 2 * D_FF), D_MODEL ** -0.5),
        "w_down": nrm((L, D_FF, D_MODEL), D_FF ** -0.5),
    }


def reference(x, mem, positions, norm_mix, w_in, qn_diff, kn_diff, lambda_q1, lambda_k1,
              lambda_q2, lambda_k2, subln_diff, qn_dil, kn_dil, qn_moba, kn_moba, w_out,
              norm_cross, norm_mem, w_mq, w_mkv, qn_mem, kn_mem, w_mo, norm_ffn,
              w_gate_up, w_down):
    B, S, _ = x.shape
    a_end = N_HEADS_DIFF
    b_end = N_HEADS_DIFF + N_HEADS_DIL
    rot = HEAD_DIM // ROPE_FRACTION
    for l in range(DEPTH):
        h = rms_norm(x, norm_mix[l])
        qkv = (h @ w_in[l]).reshape(B, S, 3, N_HEADS_MIX, HEAD_DIM)
        q, k, v = qkv[:, :, 0], qkv[:, :, 1], qkv[:, :, 2]

        lam_init = 0.8 - 0.6 * math.exp(-0.3 * l)
        lam = (jnp.exp(jnp.sum(lambda_q1[l].astype(jnp.float32) * lambda_k1[l].astype(jnp.float32)))
               - jnp.exp(jnp.sum(lambda_q2[l].astype(jnp.float32) * lambda_k2[l].astype(jnp.float32)))
               + lam_init)
        qa = diff_qk_prep(q[:, :, :a_end], qn_diff[l], positions)
        ka = diff_qk_prep(k[:, :, :a_end], kn_diff[l], positions)
        o_a = diff_attention(qa[:, :, :, 0], qa[:, :, :, 1], ka[:, :, :, 0], ka[:, :, :, 1],
                             v[:, :, :a_end], lam)
        o_a = rms_norm(o_a, subln_diff[l]) * (1.0 - lam_init)

        qb = rotary(rms_norm(q[:, :, a_end:b_end], qn_dil[l]), positions, rot)
        kb = rotary(rms_norm(k[:, :, a_end:b_end], kn_dil[l]), positions, rot)
        o_b = dilated_mixture(qb, kb, v[:, :, a_end:b_end])

        qc = rotary(rms_norm(q[:, :, b_end:], qn_moba[l]), positions, rot)
        kc = rotary(rms_norm(k[:, :, b_end:], kn_moba[l]), positions, rot)
        o_c = moba_attention(qc, kc, v[:, :, b_end:])

        mix = jnp.concatenate([o_a, o_b.astype(o_a.dtype), o_c.astype(o_a.dtype)], axis=2)
        x = x + mix.reshape(B, S, MIX_WIDTH) @ w_out[l]

        x = x + memory_cross_attention(rms_norm(x, norm_cross[l]), rms_norm(mem, norm_mem[l]),
                                       w_mq[l], w_mkv[l], w_mo[l], qn_mem[l], kn_mem[l])

        x = x + swiglu(rms_norm(x, norm_ffn[l]), w_gate_up[l], w_down[l])
    return x
```

```cpp
#include <hip/hip_runtime.h>
#include <hip/hip_cooperative_groups.h>
#include <cstdio>
#include <cstdint>
namespace cg = cooperative_groups;

typedef unsigned short bf16_t;
typedef short bf16x8 __attribute__((ext_vector_type(8)));
typedef float f32x4 __attribute__((ext_vector_type(4)));

constexpr int D_MODEL = 1024, BATCH = 2, SEQ = 8192, DEPTH = 2, NTOK = BATCH * SEQ;
constexpr int NH = 16, HD = 64, D_FF = 2816, MEM_LEN = 256, MEMW = 256;
constexpr float EPS = 1e-6f;
constexpr int NTHREADS = 512;
constexpr int LDS_BYTES = 131072 + 256;

struct Params {
    const float* x; const float* mem; const int* pos;
    const float* norm_mix; const float* w_in; const float* qn_diff; const float* kn_diff;
    const float* lq1; const float* lk1; const float* lq2; const float* lk2; const float* subln;
    const float* qn_dil; const float* kn_dil; const float* qn_moba; const float* kn_moba; const float* w_out;
    const float* norm_cross; const float* norm_mem; const float* w_mq; const float* w_mkv;
    const float* qn_mem; const float* kn_mem; const float* w_mo; const float* norm_ffn;
    const float* w_gu; const float* w_down;
    float* out; unsigned char* ws;
};

constexpr size_t OFF_CTRL = 0;
constexpr size_t OFF_BAR  = 4096;
constexpr size_t OFF_XN   = 32768;
constexpr size_t OFF_MIX  = OFF_XN + (size_t)NTOK * 1024 * 2;
constexpr size_t OFF_PART = OFF_MIX + (size_t)NTOK * 1024 * 2;
constexpr size_t OFF_Q0   = OFF_PART + (size_t)NTOK * 16 * 4;
constexpr size_t OFF_Q    = OFF_Q0;
constexpr size_t OFF_K    = OFF_Q + (size_t)NTOK * 1024 * 2;
constexpr size_t OFF_V    = OFF_K + (size_t)NTOK * 1024 * 2;
constexpr int    NVSLOT   = 28;
constexpr size_t OFF_H    = OFF_Q;
constexpr size_t OFF_QM   = OFF_Q;
constexpr size_t OFF_OM   = OFF_K;
constexpr size_t OFF_MEMN = OFF_V + (size_t)BATCH * NVSLOT * 64 * SEQ * 2;
constexpr size_t OFF_KMEM = OFF_MEMN + (size_t)2 * 512 * 1024 * 2;
constexpr size_t OFF_VMEM = OFF_KMEM + (size_t)512 * 256 * 2;
constexpr size_t OFF_KMEAN= OFF_VMEM + (size_t)512 * 256 * 2;
constexpr size_t OFF_GT   = OFF_KMEAN + (size_t)2 * 6 * 32 * 64 * 4;
constexpr size_t OFF_SB   = OFF_GT + 2 * 2 * 3 * 64 * 4;
constexpr size_t OFF_CS   = OFF_SB + 256;
constexpr size_t OFF_WB   = OFF_CS + (size_t)NTOK * 16 * 4;
constexpr size_t WB_IN = 0, WB_OUT = WB_IN + (size_t)3072 * 1024, WB_MQ = WB_OUT + (size_t)1024 * 1024, WB_MKV = WB_MQ + (size_t)256 * 1024, WB_MO = WB_MKV + (size_t)512 * 1024,
                 WB_GU = WB_MO + (size_t)1024 * 256, WB_DOWN = WB_GU + (size_t)5632 * 1024, WB_LAYER = WB_DOWN + (size_t)1024 * 2816;
constexpr size_t WS_END   = OFF_WB + 2 * WB_LAYER * 2;
static_assert((size_t)NTOK * 2816 * 2 <= OFF_MEMN - OFF_Q, "h overlay");
static_assert(WS_END <= (size_t)268435456, "workspace");

__device__ __forceinline__ bf16_t f2bf(float f) { unsigned u = __float_as_uint(f); u += 0x7fffu + ((u >> 16) & 1u); return (bf16_t)(u >> 16); }
__device__ __forceinline__ float bf2f(bf16_t h) { return __uint_as_float(((unsigned)h) << 16); }
__device__ __forceinline__ float bflo(unsigned w) { return __uint_as_float(w << 16); }
__device__ __forceinline__ float bfhi(unsigned w) { return __uint_as_float(w & 0xffff0000u); }
typedef float f32x2c __attribute__((ext_vector_type(2)));
typedef __bf16 bf16x2c __attribute__((ext_vector_type(2)));
__device__ __forceinline__ unsigned pack2(float a, float b) { const f32x2c v = {a, b}; return __builtin_bit_cast(unsigned, __builtin_convertvector(v, bf16x2c)); }
__device__ __forceinline__ float fexp2(float x) { return __builtin_amdgcn_exp2f(x); }

__device__ __forceinline__ int opaque_tid() { int t = threadIdx.x; asm volatile("" : "+v"(t)); return t; }
__device__ __forceinline__ void norm_rows(const float* __restrict__ X, const float* __restrict__ g, bf16_t* __restrict__ out, int nrows) {
    const int tid_ = opaque_tid(), lane = tid_ & 63, wid = tid_ >> 6;
    for (int row = blockIdx.x * 8 + wid; row < nrows; row += gridDim.x * 8) {
        const float4* xp = (const float4*)(X + (size_t)row * 1024);
        float4 v[4]; float ss = 0.f;
#pragma unroll
        for (int i = 0; i < 4; ++i) { v[i] = xp[lane + 64 * i]; ss += v[i].x * v[i].x + v[i].y * v[i].y + v[i].z * v[i].z + v[i].w * v[i].w; }
#pragma unroll
        for (int o = 32; o > 0; o >>= 1) ss += __shfl_xor(ss, o);
        const float rstd = rsqrtf(ss * (1.0f / 1024.0f) + EPS);
#pragma unroll
        for (int i = 0; i < 4; ++i) {
            const float4 gg = ((const float4*)g)[lane + 64 * i];
            uint2 w; w.x = pack2(v[i].x * rstd * gg.x, v[i].y * rstd * gg.y); w.y = pack2(v[i].z * rstd * gg.z, v[i].w * rstd * gg.w);
            *(uint2*)(out + (size_t)row * 1024 + (lane + 64 * i) * 4) = w;
        }
    }
}

struct CmId { __device__ __forceinline__ int operator()(int c) const { return c; } };
struct CmGU { __device__ __forceinline__ int operator()(int c) const { const int t = c >> 7, w = c & 127; return w < 64 ? (64 * t + w) : (D_FF + 64 * t + (w - 64)); } };

template <class CM, class Epi>
__device__ __forceinline__ void gemm_run(unsigned char* lds, const bf16_t* __restrict__ A, int lda, const float* __restrict__ W, int ldw, int K, int mt, int nt, int first, CM cm, Epi epi) {
    const int tid = opaque_tid(), lane = tid & 63, wid = tid >> 6, wr = wid >> 1, wc = wid & 1, fr = lane & 15, fq = lane >> 4;
    bf16_t* sA = (bf16_t*)lds;
    bf16_t* sB = sA + 128 * 40;
    float* sC = (float*)lds;
    const int ntiles = mt * nt;
    const int arow = tid >> 2, akc = (tid & 3) * 8, bk = tid >> 4, bn8 = (tid & 15) * 8;
    for (int tile = first; tile < ntiles; tile += gridDim.x) {
        const int tm = tile / nt, tn = tile % nt, m0 = tm * 128, n0 = tn * 128;
        f32x4 acc[2][4];
#pragma unroll
        for (int m = 0; m < 2; ++m)
#pragma unroll
            for (int n = 0; n < 4; ++n) acc[m][n] = (f32x4){0.f, 0.f, 0.f, 0.f};
        const bf16_t* ap = A + (size_t)(m0 + arow) * lda + akc;
        const float* bp = W + (size_t)bk * ldw + cm(n0 + bn8);
        uint4 ra = *(const uint4*)ap; float4 rb0 = *(const float4*)bp, rb1 = *(const float4*)(bp + 4);
        const int nk = K / 32;
        for (int kt = 0; kt < nk; ++kt) {
            __syncthreads();
            *(uint4*)(sA + arow * 40 + akc) = ra;
            sB[(bn8 + 0) * 40 + bk] = f2bf(rb0.x); sB[(bn8 + 1) * 40 + bk] = f2bf(rb0.y); sB[(bn8 + 2) * 40 + bk] = f2bf(rb0.z); sB[(bn8 + 3) * 40 + bk] = f2bf(rb0.w);
            sB[(bn8 + 4) * 40 + bk] = f2bf(rb1.x); sB[(bn8 + 5) * 40 + bk] = f2bf(rb1.y); sB[(bn8 + 6) * 40 + bk] = f2bf(rb1.z); sB[(bn8 + 7) * 40 + bk] = f2bf(rb1.w);
            __syncthreads();
            if (kt + 1 < nk) { ap += 32; bp += (size_t)32 * ldw; ra = *(const uint4*)ap; rb0 = *(const float4*)bp; rb1 = *(const float4*)(bp + 4); }
            bf16x8 af[2], bfr[4];
#pragma unroll
            for (int m = 0; m < 2; ++m) af[m] = *(const bf16x8*)(sA + (wr * 32 + m * 16 + fr) * 40 + fq * 8);
#pragma unroll
            for (int n = 0; n < 4; ++n) bfr[n] = *(const bf16x8*)(sB + (wc * 64 + n * 16 + fr) * 40 + fq * 8);
#pragma unroll
            for (int m = 0; m < 2; ++m)
#pragma unroll
                for (int n = 0; n < 4; ++n) acc[m][n] = __builtin_amdgcn_mfma_f32_16x16x32_bf16(af[m], bfr[n], acc[m][n], 0, 0, 0);
        }
        __syncthreads();
#pragma unroll
        for (int m = 0; m < 2; ++m)
#pragma unroll
            for (int n = 0; n < 4; ++n)
#pragma unroll
                for (int j = 0; j < 4; ++j) sC[(wr * 32 + m * 16 + fq * 4 + j) * 132 + wc * 64 + n * 16 + fr] = acc[m][n][j];
        __syncthreads();
        epi(tm, tn, sC, tid);
    }
    __syncthreads();
}

struct EpiResid {
    const float* src; float* out;
    __device__ __forceinline__ void operator()(int tm, int tn, const float* sC, int tid) const {
        const int row = tid >> 2, c0 = (tid & 3) * 32;
        const size_t off = (size_t)(tm * 128 + row) * 1024 + tn * 128 + c0;
#pragma unroll
        for (int i = 0; i < 8; ++i) {
            const float4 s = *(const float4*)(src + off + i * 4); const float4 c = *(const float4*)(sC + row * 132 + c0 + i * 4);
            float4 o; o.x = s.x + c.x; o.y = s.y + c.y; o.z = s.z + c.z; o.w = s.w + c.w; *(float4*)(out + off + i * 4) = o;
        }
    }
};
struct EpiQKV {
    const int* pos; const float* gt;
    bf16_t* q;
    __device__ __forceinline__ void operator()(int tm, int tn, const float* sC, int tid) const {
        const int which = tn >> 3;
        if (which == 2) {
            const int col = tid & 127, tg = tid >> 7, hd = (tn & 7) * 2 + (col >> 6), d = col & 63;
            const int tok0 = tm * 128 + tg * 32, bb = tok0 >> 13, s0 = tok0 & 8191;
            bf16_t* vt = q + (size_t)2 * ((size_t)NTOK * 1024);
            const float* c = sC + (tg * 32) * 132 + col;
            const int ht = tn & 7;
            const int slot = ht < 2 ? hd : (ht >= 5 ? hd - 6 : 10 + (hd - 4) * 3);
            bf16_t* dstv = vt + ((size_t)(bb * NVSLOT + slot) * 64 + d) * SEQ;
#pragma unroll
            for (int i = 0; i < 4; ++i) {
                uint4 w; w.x = pack2(c[(8 * i) * 132], c[(8 * i + 1) * 132]); w.y = pack2(c[(8 * i + 2) * 132], c[(8 * i + 3) * 132]); w.z = pack2(c[(8 * i + 4) * 132], c[(8 * i + 5) * 132]); w.w = pack2(c[(8 * i + 6) * 132], c[(8 * i + 7) * 132]);
                *(uint4*)(dstv + s0 + i * 8) = w;
            }
            if (ht >= 2 && ht < 5) {
                bf16_t* d4 = dstv + (size_t)64 * SEQ; bf16_t* d16 = dstv + (size_t)2 * 64 * SEQ;
#pragma unroll
                for (int res = 0; res < 4; ++res) {
                    uint4 w; w.x = pack2(c[(res) * 132], c[(res + 4) * 132]); w.y = pack2(c[(res + 8) * 132], c[(res + 12) * 132]); w.z = pack2(c[(res + 16) * 132], c[(res + 20) * 132]); w.w = pack2(c[(res + 24) * 132], c[(res + 28) * 132]);
                    *(uint4*)(d4 + res * 2048 + (s0 >> 2)) = w;
                }
#pragma unroll
                for (int res = 0; res < 16; ++res) *(unsigned*)(d16 + res * 512 + (s0 >> 4)) = pack2(c[res * 132], c[(res + 16) * 132]);
            }
            return;
        }
        const int row = tid >> 2, hsel = (tid >> 1) & 1, half = tid & 1;
        const int head = (tn & 7) * 2 + hsel;
        const int tok = tm * 128 + row, b = tok >> 13, s = tok & 8191;
        float v32[32];
#pragma unroll
        for (int i = 0; i < 8; ++i) { const float4 c = *(const float4*)(sC + row * 132 + hsel * 64 + half * 32 + i * 4); v32[4 * i] = c.x; v32[4 * i + 1] = c.y; v32[4 * i + 2] = c.z; v32[4 * i + 3] = c.w; }
        bf16_t* dst = q + (size_t)which * ((size_t)NTOK * 1024) + ((size_t)(b * NH + head) * SEQ + s) * 64 + half * 32;
        if (which < 2) {
            float ss = 0.f;
#pragma unroll
            for (int i = 0; i < 32; ++i) ss += v32[i] * v32[i];
            const int ht = tn & 7; const bool diff = ht < 2;
            if (!diff) ss += __shfl_xor(ss, 1);
            const float rstd = rsqrtf(ss * (diff ? (1.0f / 32.0f) : (1.0f / 64.0f)) + EPS);
            const float* g = gt + (which * 3 + (ht < 2 ? 0 : ht < 5 ? 1 : 2)) * 64;
            const int goff = diff ? 0 : half * 32;
#pragma unroll
            for (int i = 0; i < 32; ++i) v32[i] = v32[i] * rstd * g[goff + i];
            const float p = (float)pos[tok];
            if (diff) {
#pragma unroll
                for (int i = 0; i < 4; ++i) {
                    const float invf = (i == 0) ? 1.0f : (i == 1) ? 0.037606030930863934f : (i == 2) ? 0.0014142135623730951f : 5.318295896944989e-05f;
                    const float ang = p * invf; const float cs = cosf(ang), sn = sinf(ang);
                    const float x1 = v32[i], x2 = v32[i + 4]; v32[i] = x1 * cs - x2 * sn; v32[i + 4] = x2 * cs + x1 * sn;
                }
            } else if (half == 0) {
#pragma unroll
                for (int i = 0; i < 8; ++i) {
                    const float invf = (i == 0) ? 1.0f : (i == 1) ? 0.19392547244381735f : (i == 2) ? 0.037606030930863934f : (i == 3) ? 0.007292767314834156f :
                                       (i == 4) ? 0.0014142135623730951f : (i == 5) ? 0.0002742520333386866f : (i == 6) ? 5.318295896944989e-05f : 1.0313530666425395e-05f;
                    const float ang = p * invf; const float cs = cosf(ang), sn = sinf(ang);
                    const float x1 = v32[i], x2 = v32[i + 8]; v32[i] = x1 * cs - x2 * sn; v32[i + 8] = x2 * cs + x1 * sn;
                }
            }
        }
#pragma unroll
        for (int i = 0; i < 4; ++i) {
            uint4 w; w.x = pack2(v32[8 * i], v32[8 * i + 1]); w.y = pack2(v32[8 * i + 2], v32[8 * i + 3]); w.z = pack2(v32[8 * i + 4], v32[8 * i + 5]); w.w = pack2(v32[8 * i + 6], v32[8 * i + 7]);
            *(uint4*)(dst + i * 8) = w;
        }
    }
};
struct EpiHeadNorm {
    const float* gain; bf16_t* out; int ldo; int norm_tiles; bf16_t* out2;
    __device__ __forceinline__ void operator()(int tm, int tn, const float* sC, int tid) const {
        const int row = tid >> 2, hsel = (tid >> 1) & 1, half = tid & 1;
        float v32[32];
#pragma unroll
        for (int i = 0; i < 8; ++i) { const float4 c = *(const float4*)(sC + row * 132 + hsel * 64 + half * 32 + i * 4); v32[4 * i] = c.x; v32[4 * i + 1] = c.y; v32[4 * i + 2] = c.z; v32[4 * i + 3] = c.w; }
        bf16_t* dst;
        if (tn < norm_tiles) {
            float ss = 0.f;
#pragma unroll
            for (int i = 0; i < 32; ++i) ss += v32[i] * v32[i];
            ss += __shfl_xor(ss, 1);
            const float rstd = rsqrtf(ss * (1.0f / 64.0f) + EPS);
#pragma unroll
            for (int i = 0; i < 32; ++i) v32[i] = v32[i] * rstd * gain[half * 32 + i];
            dst = out + (size_t)(tm * 128 + row) * ldo + tn * 128 + hsel * 64 + half * 32;
        } else {
            const int hd = (tn - norm_tiles) * 2 + hsel, mr = tm * 128 + row, bb = mr >> 8, mi = mr & 255;
#pragma unroll
            for (int i = 0; i < 32; ++i) out2[((size_t)(bb * 4 + hd) * 64 + half * 32 + i) * 256 + mi] = f2bf(v32[i]);
            return;
        }
#pragma unroll
        for (int i = 0; i < 4; ++i) {
            uint4 w; w.x = pack2(v32[8 * i], v32[8 * i + 1]); w.y = pack2(v32[8 * i + 2], v32[8 * i + 3]); w.z = pack2(v32[8 * i + 4], v32[8 * i + 5]); w.w = pack2(v32[8 * i + 6], v32[8 * i + 7]);
            *(uint4*)(dst + i * 8) = w;
        }
    }
};
struct EpiSwiglu {
    bf16_t* h;
    __device__ __forceinline__ void operator()(int tm, int tn, const float* sC, int tid) const {
        const int row = tid >> 2, c0 = (tid & 3) * 16;
        float o[16];
#pragma unroll
        for (int i = 0; i < 16; ++i) { const float g = sC[row * 132 + c0 + i], u = sC[row * 132 + 64 + c0 + i]; o[i] = g / (1.0f + __expf(-g)) * u; }
        bf16_t* dst = h + (size_t)(tm * 128 + row) * D_FF + tn * 64 + c0;
#pragma unroll
        for (int i = 0; i < 2; ++i) {
            uint4 w; w.x = pack2(o[8 * i], o[8 * i + 1]); w.y = pack2(o[8 * i + 2], o[8 * i + 3]); w.z = pack2(o[8 * i + 4], o[8 * i + 5]); w.w = pack2(o[8 * i + 6], o[8 * i + 7]);
            *(uint4*)(dst + i * 8) = w;
        }
    }
};

namespace pg8 {
#define PG8_LAS __attribute__((address_space(3)))
typedef unsigned short bf16_t;
typedef short bf16x8 __attribute__((ext_vector_type(8)));
typedef float f32x4 __attribute__((ext_vector_type(4)));
typedef unsigned u32x4 __attribute__((ext_vector_type(4)));
constexpr int BM = 256, BK = 64, HALF = 128, HTB = HALF * BK * 2  , STAGE_BYTES = 8 * HTB, NXCD = 8, WGM = 8;

__host__ __device__ __forceinline__ int lds_byte(int r, int c) { const int st = (r >> 4) * 2 + (c >> 5), rr = r & 15, cc = c & 31, ob = rr * 64 + cc * 2; return st * 1024 + (ob ^ (((ob >> 9) & 1) << 5)); }
__host__ __device__ __forceinline__ void stage_rc(int b, int& R, int& C) { const int st = b / 1024, sb = b % 1024, swz = sb ^ (((sb >> 9) & 1) << 5); R = (st >> 1) * 16 + swz / 64; C = (st & 1) * 32 + (swz % 64) / 2; }
__host__ __device__ __forceinline__ int perm32(int rho) { const int n = rho >> 4, i = rho & 15; return 8 * (i >> 2) + 4 * n + (i & 3); }

struct Unit { int pm, pn; };
struct Gemm { const bf16_t* A; const bf16_t* Bt; int M, N, K; };

struct StaticOrder {
    int nM, nN, nwg, G, c;
    __host__ __device__ void init(int M, int N, int G_, int c_) { nM = M / BM; nN = N / BM; nwg = nM * nN; G = G_; c = c_; }
    __host__ __device__ bool next(int i, Unit& u) const {
        const long L = (long)i * G + c; if (L >= nwg) return false;
        int wgid = (int)L; { const int q = nwg / NXCD, r = nwg % NXCD, xcd = wgid % NXCD, off = wgid / NXCD; wgid = (xcd < r ? xcd * (q + 1) : r * (q + 1) + (xcd - r) * q) + off; }
        const int nig = WGM * nN, gid = wgid / nig, fm = gid * WGM, gsz = (nM - fm) < WGM ? (nM - fm) : WGM;
        u.pm = fm + ((wgid % nig) % gsz); u.pn = (wgid % nig) / gsz; return true;
    }
    __device__ __forceinline__ void a_ready(const Unit&) const {}
    __device__ __forceinline__ void done(const Unit&) const {}
};

__device__ __forceinline__ unsigned cvt_pk_bf16(float lo, float hi) { const ::f32x2c v = {lo, hi}; return __builtin_bit_cast(unsigned, __builtin_convertvector(v, ::bf16x2c)); }
typedef unsigned u32x4 __attribute__((ext_vector_type(4)));
struct EpiResid2 {
    static constexpr bool PERM = false, AFTER_DRAIN = false;
    const float* src; float* out; bf16_t* xb; float* part;
    __device__ __forceinline__ void operator()(const f32x4 (&acc)[2][2][4][2], const Unit& u, int wr, int wc, int fr, int fq) const {
#pragma unroll
        for (int ai = 0; ai < 2; ++ai) {
            f32x4 sv[4][2][2];
#pragma unroll
            for (int m = 0; m < 4; ++m) {
                const size_t off = (size_t)(u.pm * BM + ai * HALF + wr * 64 + m * 16 + fr) * 1024 + u.pn * BM + wc * 32 + 4 * fq;
#pragma unroll
                for (int bj = 0; bj < 2; ++bj)
#pragma unroll
                    for (int n = 0; n < 2; ++n) sv[m][bj][n] = *(const f32x4*)(src + off + bj * HALF + n * 16);
            }
#pragma unroll
            for (int m = 0; m < 4; ++m) {
                const int row = u.pm * BM + ai * HALF + wr * 64 + m * 16 + fr;
                const size_t off = (size_t)row * 1024 + u.pn * BM + wc * 32 + 4 * fq;
                float ss = 0.f;
#pragma unroll
                for (int bj = 0; bj < 2; ++bj)
#pragma unroll
                    for (int n = 0; n < 2; ++n) {
                        const size_t o = off + bj * HALF + n * 16; const f32x4 r = sv[m][bj][n] + acc[ai][bj][m][n];
                        *(f32x4*)(out + o) = r;
                        if (xb) { ss += r[0] * r[0] + r[1] * r[1] + r[2] * r[2] + r[3] * r[3]; uint2 w; w.x = cvt_pk_bf16(r[0], r[1]); w.y = cvt_pk_bf16(r[2], r[3]); *(uint2*)(xb + o) = w; }
                    }
                if (xb) {
                    ss += __shfl_xor(ss, 16); ss += __shfl_xor(ss, 32);
                    if (fq == 0) part[(size_t)row * 16 + u.pn * 4 + wc] = ss;
                }
            }
        }
    }
};
__device__ __forceinline__ float row_rstd(const float* part, int row) {
    const f32x4* p = (const f32x4*)(part + (size_t)row * 16);
    const f32x4 a = p[0], b = p[1], c = p[2], d = p[3];
    const float ss = ((a[0] + a[1]) + (a[2] + a[3])) + ((b[0] + b[1]) + (b[2] + b[3])) + ((c[0] + c[1]) + (c[2] + c[3])) + ((d[0] + d[1]) + (d[2] + d[3]));
    float r = rsqrtf(ss * (1.0f / 1024.0f) + 1e-6f);
    asm volatile("" : "+v"(r) : : "memory");
    return r;
}
struct EpiQK {
    static constexpr bool PERM = true, AFTER_DRAIN = false;
    const float* gt; const float* cs; bf16_t* qk; const float* part;
    __device__ __forceinline__ void operator()(const f32x4 (&acc)[2][2][4][2], const Unit& u, int wr, int wc, int fr, int fq) const {
        const int which = u.pn >> 2, head = (u.pn & 3) * 4 + wc, type = head < 4 ? 0 : (head < 10 ? 1 : 2);
        const bool diff = type == 0;
        const float* g = gt + (which * 3 + type) * 64;
        f32x4 gv[2][2];
#pragma unroll
        for (int bj = 0; bj < 2; ++bj)
#pragma unroll
            for (int n = 0; n < 2; ++n) gv[bj][n] = *(const f32x4*)(g + (diff ? 0 : 32 * bj) + 8 * fq + 4 * n);
        bf16_t* base = qk + (size_t)which * ((size_t)16384 * 1024);
#pragma unroll
        for (int ai = 0; ai < 2; ++ai)
#pragma unroll
            for (int m = 0; m < 4; ++m) {
                const int tok = u.pm * BM + ai * HALF + wr * 64 + m * 16 + fr, b = tok >> 13, sp = tok & 8191;
                f32x4 v[2][2];
                const float rs0 = row_rstd(part, tok);
#pragma unroll
                for (int bj = 0; bj < 2; ++bj)
#pragma unroll
                    for (int n = 0; n < 2; ++n) v[bj][n] = acc[ai][bj][m][n] * rs0;
                const f32x4* cp = (const f32x4*)(cs + (size_t)tok * 16);
                const f32x4 c0 = cp[0], c1 = cp[1], c2 = cp[2], c3 = cp[3];
                if (diff) {
#pragma unroll
                    for (int bj = 0; bj < 2; ++bj) {
                        float ss = 0.f;
#pragma unroll
                        for (int n = 0; n < 2; ++n) ss += v[bj][n][0] * v[bj][n][0] + v[bj][n][1] * v[bj][n][1] + v[bj][n][2] * v[bj][n][2] + v[bj][n][3] * v[bj][n][3];
                        ss += __shfl_xor(ss, 16); ss += __shfl_xor(ss, 32);
                        const float rstd = rsqrtf(ss * (1.0f / 32.0f) + 1e-6f);
#pragma unroll
                        for (int n = 0; n < 2; ++n) v[bj][n] = v[bj][n] * rstd * gv[bj][n];
                        if (fq == 0) {
                            const float cc[4] = {c0[0], c1[0], c2[0], c3[0]}, sn[4] = {c0[1], c1[1], c2[1], c3[1]};
#pragma unroll
                            for (int e = 0; e < 4; ++e) { const float x1 = v[bj][0][e], x2 = v[bj][1][e]; v[bj][0][e] = x1 * cc[e] - x2 * sn[e]; v[bj][1][e] = x2 * cc[e] + x1 * sn[e]; }
                        }
                    }
                } else {
                    float ss = 0.f;
#pragma unroll
                    for (int bj = 0; bj < 2; ++bj)
#pragma unroll
                        for (int n = 0; n < 2; ++n) ss += v[bj][n][0] * v[bj][n][0] + v[bj][n][1] * v[bj][n][1] + v[bj][n][2] * v[bj][n][2] + v[bj][n][3] * v[bj][n][3];
                    ss += __shfl_xor(ss, 16); ss += __shfl_xor(ss, 32);
                    const float rstd = rsqrtf(ss * (1.0f / 64.0f) + 1e-6f);
#pragma unroll
                    for (int bj = 0; bj < 2; ++bj)
#pragma unroll
                        for (int n = 0; n < 2; ++n) v[bj][n] = v[bj][n] * rstd * gv[bj][n];
                    const float cc[8] = {c0[0], c0[2], c1[0], c1[2], c2[0], c2[2], c3[0], c3[2]}, sn[8] = {c0[1], c0[3], c1[1], c1[3], c2[1], c2[3], c3[1], c3[3]};
#pragma unroll
                    for (int n = 0; n < 2; ++n)
#pragma unroll
                        for (int e = 0; e < 4; ++e) {
                            const float mine = v[0][n][e], other = __shfl_xor(mine, 16);
                            const float sgn = fq == 0 ? -1.0f : 1.0f;
                            const float rot = mine * cc[4 * n + e] + sgn * other * sn[4 * n + e];
                            v[0][n][e] = fq < 2 ? rot : mine;
                        }
                }
                bf16_t* dst = base + ((size_t)(b * 16 + head) * 8192 + sp) * 64 + 8 * fq;
#pragma unroll
                for (int bj = 0; bj < 2; ++bj) {
                    u32x4 w; w.x = cvt_pk_bf16(v[bj][0][0], v[bj][0][1]); w.y = cvt_pk_bf16(v[bj][0][2], v[bj][0][3]); w.z = cvt_pk_bf16(v[bj][1][0], v[bj][1][1]); w.w = cvt_pk_bf16(v[bj][1][2], v[bj][1][3]);
                    *(u32x4*)(dst + 32 * bj) = w;
                }
            }
    }
};
struct EpiVT {
    static constexpr bool PERM = true, AFTER_DRAIN = false;
    bf16_t* vt; const float* part;
    __device__ __forceinline__ void operator()(const f32x4 (&acc)[2][2][4][2], const Unit& u, int wr, int wc, int fr, int fq) const {
        f32x4 rsa[2], rsc[2];
#pragma unroll
        for (int bj = 0; bj < 2; ++bj) {
            const int tok0 = u.pn * BM + bj * HALF + wc * 32 + 8 * fq;
#pragma unroll
            for (int e = 0; e < 4; ++e) { rsa[bj][e] = row_rstd(part, tok0 + e); rsc[bj][e] = row_rstd(part, tok0 + 4 + e); }
        }
#pragma unroll
        for (int ai = 0; ai < 2; ++ai) {
            const int head = u.pm * 4 + ai * 2 + wr;
            const bool dil = head >= 4 && head < 10;
            const int slot = head < 4 ? head : (head >= 10 ? head - 6 : 10 + (head - 4) * 3);
#pragma unroll
            for (int m = 0; m < 4; ++m) {
                const int d = m * 16 + fr;
#pragma unroll
                for (int bj = 0; bj < 2; ++bj) {
                    const int tok0 = u.pn * BM + bj * HALF + wc * 32 + 8 * fq, b = tok0 >> 13, sp = tok0 & 8191;
                    const f32x4 a = acc[ai][bj][m][0] * rsa[bj], c = acc[ai][bj][m][1] * rsc[bj];
                    bf16_t* dst = vt + ((size_t)(b * 28 + slot) * 64 + d) * 8192;
                    u32x4 w; w.x = cvt_pk_bf16(a[0], a[1]); w.y = cvt_pk_bf16(a[2], a[3]); w.z = cvt_pk_bf16(c[0], c[1]); w.w = cvt_pk_bf16(c[2], c[3]);
                    *(u32x4*)(dst + sp) = w;
                    if (dil) {
                        bf16_t* d4 = dst + (size_t)64 * 8192; bf16_t* d16 = dst + (size_t)128 * 8192;
#pragma unroll
                        for (int e = 0; e < 4; ++e) *(unsigned*)(d4 + e * 2048 + (sp >> 2)) = cvt_pk_bf16(a[e], c[e]);
#pragma unroll
                        for (int e = 0; e < 4; ++e) {
                            const unsigned pa = cvt_pk_bf16(a[e], c[e]);
                            d16[((sp & 15) + e) * 512 + (sp >> 4)] = (bf16_t)(pa & 0xffffu);
                            d16[((sp & 15) + e + 4) * 512 + (sp >> 4)] = (bf16_t)(pa >> 16);
                        }
                    }
                }
            }
        }
    }
};
struct EpiHead2 {
    static constexpr bool PERM = true, AFTER_DRAIN = false;
    const float* gain; bf16_t* out; bf16_t* vmt; const float* part;
    __device__ __forceinline__ void operator()(const f32x4 (&acc)[2][2][4][2], const Unit& u, int wr, int wc, int fr, int fq) const {
        f32x4 gv[2][2];
#pragma unroll
        for (int bj = 0; bj < 2; ++bj)
#pragma unroll
            for (int n = 0; n < 2; ++n) gv[bj][n] = *(const f32x4*)(gain + 32 * bj + 8 * fq + 4 * n);
#pragma unroll
        for (int ai = 0; ai < 2; ++ai)
#pragma unroll
            for (int m = 0; m < 4; ++m) {
                const int row = u.pm * BM + ai * HALF + wr * 64 + m * 16 + fr;
                if (u.pn == 0) {
                    const float rs0 = part ? row_rstd(part, row) : 1.0f;
                    float ss = 0.f;
#pragma unroll
                    for (int bj = 0; bj < 2; ++bj)
#pragma unroll
                        for (int n = 0; n < 2; ++n) { const f32x4 x = acc[ai][bj][m][n] * rs0; ss += x[0] * x[0] + x[1] * x[1] + x[2] * x[2] + x[3] * x[3]; }
                    ss += __shfl_xor(ss, 16); ss += __shfl_xor(ss, 32);
                    const float rstd = rsqrtf(ss * (1.0f / 64.0f) + 1e-6f) * rs0;
                    bf16_t* dst = out + (size_t)row * 256 + 64 * wc + 8 * fq;
#pragma unroll
                    for (int bj = 0; bj < 2; ++bj) {
                        const f32x4 x0 = acc[ai][bj][m][0] * rstd * gv[bj][0], x1 = acc[ai][bj][m][1] * rstd * gv[bj][1];
                        u32x4 w; w.x = cvt_pk_bf16(x0[0], x0[1]); w.y = cvt_pk_bf16(x0[2], x0[3]); w.z = cvt_pk_bf16(x1[0], x1[1]); w.w = cvt_pk_bf16(x1[2], x1[3]);
                        *(u32x4*)(dst + 32 * bj) = w;
                    }
                } else {
                    const int b = row >> 8, mi = row & 255;
#pragma unroll
                    for (int bj = 0; bj < 2; ++bj)
#pragma unroll
                        for (int n = 0; n < 2; ++n)
#pragma unroll
                            for (int e = 0; e < 4; ++e) {
                                const unsigned pk = cvt_pk_bf16(acc[ai][bj][m][n][e], 0.f);
                                vmt[((size_t)(b * 4 + wc) * 64 + 32 * bj + 8 * fq + 4 * n + e) * 256 + mi] = (bf16_t)(pk & 0xffffu);
                            }
                }
            }
    }
};
struct EpiSwiglu2 {
    static constexpr bool PERM = true, AFTER_DRAIN = false;
    bf16_t* h; const float* part;
    __device__ __forceinline__ void operator()(const f32x4 (&acc)[2][2][4][2], const Unit& u, int wr, int wc, int fr, int fq) const {
#pragma unroll
        for (int ai = 0; ai < 2; ++ai)
#pragma unroll
            for (int m = 0; m < 4; ++m) {
                const int row = u.pm * BM + ai * HALF + wr * 64 + m * 16 + fr;
                const float rs0 = row_rstd(part, row);
                float o[8];
#pragma unroll
                for (int n = 0; n < 2; ++n)
#pragma unroll
                    for (int e = 0; e < 4; ++e) { const float g = acc[ai][0][m][n][e] * rs0, up = acc[ai][1][m][n][e] * rs0; o[4 * n + e] = g * __builtin_amdgcn_rcpf(1.0f + __expf(-g)) * up; }
                u32x4 w; w.x = cvt_pk_bf16(o[0], o[1]); w.y = cvt_pk_bf16(o[2], o[3]); w.z = cvt_pk_bf16(o[4], o[5]); w.w = cvt_pk_bf16(o[6], o[7]);
                *(u32x4*)(h + (size_t)row * 2816 + u.pn * 128 + wc * 32 + 8 * fq) = w;
            }
    }
};
template <class Epi, class Sched, bool ALIGN_EPI = false, bool SP2 = false>
__device__ __forceinline__ void gemm_phase(PG8_LAS unsigned char* lds, const Gemm g, const Sched& S, const Epi& E) {
    const int tid = opaque_tid(), wid = __builtin_amdgcn_readfirstlane(tid >> 6), lane = tid & 63, wr = wid >> 2, wc = wid & 3, fr = lane & 15, fq = lane >> 4;
    const int K = g.K, nt = K / BK;
    unsigned voffA[2], voffB[2];
#pragma unroll
    for (int i = 0; i < 2; ++i) { int R, C; stage_rc(tid * 16 + i * 8192, R, C); const int Rb = Epi::PERM ? ((R & ~31) + perm32(R & 31)) : R;
        voffA[i] = (unsigned)(R * K + C) * 2u; voffB[i] = (unsigned)(Rb * K + C) * 2u; }
    const size_t kstep = (size_t)(BK * 2);
    const size_t hstep = (size_t)HALF * K * 2;
    const size_t tstep = 2 * hstep;
    const unsigned ldsw = (unsigned)wid * 1024u;
    const int aoff = lds_byte(wr * 64 + fr, fq * 8), boff = lds_byte(wc * 32 + fr, fq * 8);
#define PG8_SA(b, h) (((b) * 2 + (h)) * HTB)
#define PG8_SB(b, h) ((4 + (b) * 2 + (h)) * HTB)
#define PG8_STAGE(bufoff, gbase, voff) do { _Pragma("unroll") for (int _i = 0; _i < 2; ++_i) \
        __builtin_amdgcn_global_load_lds((const unsigned*)((const char*)(gbase) + (voff)[_i]), (PG8_LAS unsigned*)(lds + (bufoff) + ldsw + _i * 8192), 16, 0, 0); } while (0)
#define PG8_LDA(dst, b, h) do { _Pragma("unroll") for (int m = 0; m < 4; ++m) _Pragma("unroll") for (int k = 0; k < 2; ++k) dst[m][k] = *(const PG8_LAS bf16x8*)(lds + PG8_SA(b, h) + aoff + m * 2048 + k * 1024); } while (0)
#define PG8_LDB(dst, b, h) do { _Pragma("unroll") for (int n = 0; n < 2; ++n) _Pragma("unroll") for (int k = 0; k < 2; ++k) dst[n][k] = *(const PG8_LAS bf16x8*)(lds + PG8_SB(b, h) + boff + n * 2048 + k * 1024); } while (0)
#define PG8_MMA(ai, bj, At, Bt) do { __builtin_amdgcn_s_setprio(1); _Pragma("unroll") for (int m = 0; m < 4; ++m) _Pragma("unroll") for (int n = 0; n < 2; ++n) _Pragma("unroll") for (int k = 0; k < 2; ++k) \
        acc[ai][bj][m][n] = __builtin_amdgcn_mfma_f32_16x16x32_bf16(Bt[n][k], At[m][k], acc[ai][bj][m][n], 0, 0, 0); __builtin_amdgcn_s_setprio(0); } while (0)
#define PG8_WAIT_V(n) asm volatile("s_waitcnt vmcnt(" #n ")" ::: "memory")
#define PG8_WAIT_L(n) asm volatile("s_waitcnt lgkmcnt(" #n ")" ::: "memory")
#define PG8_BAR __builtin_amdgcn_s_barrier()
#define PG8_SCHED __builtin_amdgcn_sched_barrier(0)
    Unit cur, nxt; int ui = 0;
    if (!S.next(0, cur)) return;
    f32x4 acc[2][2][4][2];
#pragma unroll
    for (int a = 0; a < 2; ++a)
#pragma unroll
        for (int b = 0; b < 2; ++b)
#pragma unroll
            for (int m = 0; m < 4; ++m)
#pragma unroll
                for (int n = 0; n < 2; ++n) acc[a][b][m][n] = (f32x4){0.f, 0.f, 0.f, 0.f};
    bf16x8 At[4][2], B0[2][2], B1[2][2];
    const char* cA = (const char*)g.A + (size_t)cur.pm * tstep; const char* cB = (const char*)g.Bt + (size_t)cur.pn * tstep;
    S.a_ready(cur);
    if constexpr (SP2) {
        PG8_STAGE(PG8_SB(0, 0), cB, voffB); PG8_STAGE(PG8_SB(0, 1), cB + hstep, voffB); PG8_STAGE(PG8_SA(0, 0), cA, voffA); PG8_STAGE(PG8_SA(0, 1), cA + hstep, voffA);
        if (wr == 1) PG8_BAR;
        PG8_WAIT_V(2); PG8_BAR;
        PG8_STAGE(PG8_SB(1, 0), cB + kstep, voffB); PG8_STAGE(PG8_SA(1, 0), cA + kstep, voffA); PG8_STAGE(PG8_SB(1, 1), cB + hstep + kstep, voffB);
        PG8_WAIT_V(6); PG8_BAR;
    } else {
        PG8_STAGE(PG8_SB(0, 0), cB, voffB); PG8_STAGE(PG8_SA(0, 0), cA, voffA); PG8_STAGE(PG8_SB(0, 1), cB + hstep, voffB); PG8_STAGE(PG8_SA(0, 1), cA + hstep, voffA);
        if (wr == 1) PG8_BAR;
        PG8_WAIT_V(4); PG8_BAR;
        PG8_STAGE(PG8_SB(1, 0), cB + kstep, voffB); PG8_STAGE(PG8_SA(1, 0), cA + kstep, voffA); PG8_STAGE(PG8_SB(1, 1), cB + hstep + kstep, voffB);
        PG8_WAIT_V(6); PG8_BAR;
    }
    for (;;) {
        const bool has_next = S.next(ui + 1, nxt);
        const char* nA = has_next ? (const char*)g.A + (size_t)nxt.pm * tstep : cA; const char* nB = has_next ? (const char*)g.Bt + (size_t)nxt.pn * tstep : cB;
        for (int t = 0; t < nt; t += 2) {
            const bool last = (t == nt - 2);
            const char* a1 = cA + (size_t)(t + 1) * kstep;
            const char* a2 = last ? nA : cA + (size_t)(t + 2) * kstep; const char* b2 = last ? nB : cB + (size_t)(t + 2) * kstep;
            const char* a3 = a2 + kstep; const char* b3 = b2 + kstep;
            if (last && has_next) S.a_ready(nxt);
            if constexpr (SP2) {
            PG8_LDB(B0, 0, 0); PG8_LDB(B1, 0, 1); PG8_SCHED; PG8_LDA(At, 0, 0); PG8_STAGE(PG8_SA(1, 1), a1 + hstep, voffA);
            PG8_WAIT_V(8); PG8_WAIT_L(0); PG8_BAR; PG8_MMA(0, 0, At, B0); PG8_MMA(0, 1, At, B1); PG8_BAR; PG8_SCHED;
            PG8_LDA(At, 0, 1); PG8_STAGE(PG8_SB(0, 0), b2, voffB); PG8_STAGE(PG8_SB(0, 1), b2 + hstep, voffB); PG8_STAGE(PG8_SA(0, 0), a2, voffA);
            PG8_WAIT_V(8); PG8_WAIT_L(0); PG8_BAR; PG8_MMA(1, 0, At, B0); PG8_MMA(1, 1, At, B1); PG8_BAR; PG8_SCHED;
            PG8_LDB(B0, 1, 0); PG8_LDB(B1, 1, 1); PG8_SCHED; PG8_LDA(At, 1, 0); PG8_STAGE(PG8_SA(0, 1), a2 + hstep, voffA);
            PG8_WAIT_V(8); PG8_WAIT_L(0); PG8_BAR; PG8_MMA(0, 0, At, B0); PG8_MMA(0, 1, At, B1); PG8_BAR; PG8_SCHED;
            PG8_LDA(At, 1, 1); PG8_STAGE(PG8_SB(1, 0), b3, voffB); PG8_STAGE(PG8_SB(1, 1), b3 + hstep, voffB); PG8_STAGE(PG8_SA(1, 0), a3, voffA);
            PG8_WAIT_V(8); PG8_WAIT_L(0); PG8_BAR; PG8_MMA(1, 0, At, B0); PG8_MMA(1, 1, At, B1); PG8_BAR; PG8_SCHED;
            } else {
            PG8_LDB(B0, 0, 0); PG8_SCHED; PG8_LDA(At, 0, 0); PG8_STAGE(PG8_SA(1, 1), a1 + hstep, voffA);
            PG8_WAIT_L(8); PG8_BAR; PG8_WAIT_L(0); PG8_MMA(0, 0, At, B0); PG8_BAR; PG8_SCHED;
            PG8_LDB(B1, 0, 1); PG8_STAGE(PG8_SB(0, 0), b2, voffB);
            PG8_BAR; PG8_WAIT_L(0); PG8_MMA(0, 1, At, B1); PG8_BAR;
            PG8_LDA(At, 0, 1); PG8_STAGE(PG8_SA(0, 0), a2, voffA);
            PG8_BAR; PG8_WAIT_L(0); PG8_MMA(1, 0, At, B0); PG8_BAR; PG8_SCHED;
            PG8_STAGE(PG8_SB(0, 1), b2 + hstep, voffB);
            PG8_WAIT_V(6); PG8_BAR; PG8_MMA(1, 1, At, B1); PG8_BAR;
            PG8_LDB(B0, 1, 0); PG8_SCHED; PG8_LDA(At, 1, 0); PG8_STAGE(PG8_SA(0, 1), a2 + hstep, voffA);
            PG8_WAIT_L(8); PG8_BAR; PG8_WAIT_L(0); PG8_MMA(0, 0, At, B0); PG8_BAR; PG8_SCHED;
            PG8_LDB(B1, 1, 1); PG8_STAGE(PG8_SB(1, 0), b3, voffB);
            PG8_BAR; PG8_WAIT_L(0); PG8_MMA(0, 1, At, B1); PG8_BAR;
            PG8_LDA(At, 1, 1); PG8_STAGE(PG8_SA(1, 0), a3, voffA);
            PG8_BAR; PG8_WAIT_L(0); PG8_MMA(1, 0, At, B0); PG8_BAR; PG8_SCHED;
            PG8_STAGE(PG8_SB(1, 1), b3 + hstep, voffB);
            PG8_WAIT_V(6); PG8_BAR; PG8_MMA(1, 1, At, B1); PG8_BAR;
            }
        }
        if constexpr (ALIGN_EPI) { if (wr == 0) PG8_BAR; }
        if constexpr (!Epi::AFTER_DRAIN) { E(acc, cur, wr, wc, fr, fq); S.done(cur); }
        if (!has_next) break;
#pragma unroll
        for (int a = 0; a < 2; ++a)
#pragma unroll
            for (int b = 0; b < 2; ++b)
#pragma unroll
                for (int m = 0; m < 4; ++m)
#pragma unroll
                    for (int n = 0; n < 2; ++n) acc[a][b][m][n] = (f32x4){0.f, 0.f, 0.f, 0.f};
        cur = nxt; cA = nA; cB = nB; ++ui;
        if constexpr (ALIGN_EPI) { if (wr == 1) PG8_BAR; }
    }
    PG8_WAIT_V(0);
    if constexpr (!ALIGN_EPI) { if (wr == 0) PG8_BAR; }
    PG8_BAR;
    if constexpr (Epi::AFTER_DRAIN) { E.fused(acc, cur, wr, wc, fr, fq, lds, wid, lane); S.done(cur); }
#undef PG8_SA
#undef PG8_SB
#undef PG8_STAGE
#undef PG8_LDA
#undef PG8_LDB
#undef PG8_MMA
#undef PG8_WAIT_V
#undef PG8_WAIT_L
#undef PG8_BAR
#undef PG8_SCHED
}
}

__device__ __forceinline__ void load_row64(const bf16_t* p, float* f) {
#pragma unroll
    for (int i = 0; i < 8; ++i) { const uint4 w = ((const uint4*)p)[i]; f[8 * i] = bflo(w.x); f[8 * i + 1] = bfhi(w.x); f[8 * i + 2] = bflo(w.y); f[8 * i + 3] = bfhi(w.y); f[8 * i + 4] = bflo(w.z); f[8 * i + 5] = bfhi(w.z); f[8 * i + 6] = bflo(w.w); f[8 * i + 7] = bfhi(w.w); }
}
__device__ __forceinline__ void store_row64(bf16_t* p, const float* f) {
#pragma unroll
    for (int i = 0; i < 8; ++i) { uint4 w; w.x = pack2(f[8 * i], f[8 * i + 1]); w.y = pack2(f[8 * i + 2], f[8 * i + 3]); w.z = pack2(f[8 * i + 4], f[8 * i + 5]); w.w = pack2(f[8 * i + 6], f[8 * i + 7]); ((uint4*)p)[i] = w; }
}
template <int NCH> __device__ __forceinline__ float dotk(const bf16_t* kp, const float* q) {
    float s = 0.f;
#pragma unroll
    for (int c = 0; c < NCH; ++c) { const uint4 w = ((const uint4*)kp)[c];
        s += q[8 * c] * bflo(w.x) + q[8 * c + 1] * bfhi(w.x) + q[8 * c + 2] * bflo(w.y) + q[8 * c + 3] * bfhi(w.y) + q[8 * c + 4] * bflo(w.z) + q[8 * c + 5] * bfhi(w.z) + q[8 * c + 6] * bflo(w.w) + q[8 * c + 7] * bfhi(w.w); }
    return s;
}
__device__ __forceinline__ void pv_acc(const bf16_t* vp, float a, float p, float* O) {
#pragma unroll
    for (int c = 0; c < 8; ++c) { const uint4 w = ((const uint4*)vp)[c];
        O[8 * c] = O[8 * c] * a + p * bflo(w.x); O[8 * c + 1] = O[8 * c + 1] * a + p * bfhi(w.x); O[8 * c + 2] = O[8 * c + 2] * a + p * bflo(w.y); O[8 * c + 3] = O[8 * c + 3] * a + p * bfhi(w.y);
        O[8 * c + 4] = O[8 * c + 4] * a + p * bflo(w.z); O[8 * c + 5] = O[8 * c + 5] * a + p * bfhi(w.z); O[8 * c + 6] = O[8 * c + 6] * a + p * bflo(w.w); O[8 * c + 7] = O[8 * c + 7] * a + p * bfhi(w.w); }
}
__device__ __forceinline__ void osm_update(float sc, const bf16_t* vp, float& m, float& l, float* O) {
    const float mn = fmaxf(m, sc), a = __expf(m - mn), p = __expf(sc - mn);
    l = l * a + p; m = mn;
    pv_acc(vp, a, p, O);
}

__device__ __forceinline__ void attn_diff_unit(const Params& P, int l, int u, float lam, float lam_init) {
    const int lane = opaque_tid() & 63, st = lane >> 5;
    const int c = 255 - (u >> 3), bh = u & 7, b = bh >> 2, h = bh & 3;
    const int s = c * 32 + (lane & 31);
    const bf16_t* Q = (const bf16_t*)(P.ws + OFF_Q) + ((size_t)(b * NH + h) * SEQ) * 64 + st * 32;
    const bf16_t* K = (const bf16_t*)(P.ws + OFF_K) + ((size_t)(b * NH + h) * SEQ) * 64 + st * 32;
    const bf16_t* V = (const bf16_t*)(P.ws + OFF_V) + ((size_t)(b * NH + h) * SEQ) * 64;
    float q[32];
#pragma unroll
    for (int i = 0; i < 4; ++i) { const uint4 w = ((const uint4*)(Q + (size_t)s * 64))[i]; q[8 * i] = bflo(w.x); q[8 * i + 1] = bfhi(w.x); q[8 * i + 2] = bflo(w.y); q[8 * i + 3] = bfhi(w.y); q[8 * i + 4] = bflo(w.z); q[8 * i + 5] = bfhi(w.z); q[8 * i + 6] = bflo(w.w); q[8 * i + 7] = bfhi(w.w); }
    const float scale = 0.17677669529663687f;
#pragma unroll
    for (int i = 0; i < 32; ++i) q[i] *= scale;
    float O[64];
#pragma unroll
    for (int i = 0; i < 64; ++i) O[i] = 0.f;
    float m = -1e30f, lsum = 0.f;
    const int jmax = c * 32 + 31;
#pragma unroll 1
    for (int j = 0; j <= jmax; ++j) {
        const float sc = dotk<4>(K + (size_t)j * 64, q);
        if (j <= s) osm_update(sc, V + (size_t)j * 64, m, lsum, O);
    }
    const float inv = (st == 0) ? (1.0f / lsum) : (-lam / lsum);
    float ss = 0.f;
#pragma unroll
    for (int i = 0; i < 64; ++i) { float v = O[i] * inv; v += __shfl_xor(v, 32); O[i] = v; ss += v * v; }
    const float rstd = rsqrtf(ss * (1.0f / 64.0f) + EPS) * (1.0f - lam_init);
    const float* g = P.subln + l * 64;
#pragma unroll
    for (int i = 0; i < 64; ++i) O[i] = O[i] * rstd * g[i];
    if (st == 0) store_row64((bf16_t*)(P.ws + OFF_MIX) + (size_t)(b * SEQ + s) * 1024 + h * 64, O);
}

__device__ __forceinline__ void attn_dil_unit(const Params& P, int u) {
    const int lane = opaque_tid() & 63;
    const int c = u / 12, bh = u % 12, b = bh / 6, h = 4 + bh % 6;
    const int s = c * 64 + lane;
    const bf16_t* Q = (const bf16_t*)(P.ws + OFF_Q) + ((size_t)(b * NH + h) * SEQ) * 64;
    const bf16_t* K = (const bf16_t*)(P.ws + OFF_K) + ((size_t)(b * NH + h) * SEQ) * 64;
    const bf16_t* V = (const bf16_t*)(P.ws + OFF_V) + ((size_t)(b * NH + h) * SEQ) * 64;
    float q[64]; load_row64(Q + (size_t)s * 64, q);
#pragma unroll
    for (int i = 0; i < 64; ++i) q[i] *= 0.125f;
    float O[64];
#pragma unroll
    for (int i = 0; i < 64; ++i) O[i] = 0.f;
    float m = -1e30f, lsum = 0.f;
    for (int br = 0; br < 3; ++br) {
        const int d = br == 0 ? 1 : br == 1 ? 4 : 16;
#pragma unroll 1
        for (int t = 0; t <= 128; ++t) {
            const int kp = s - t * d;
            if (kp >= 0) {
                const float sc = dotk<8>(K + (size_t)kp * 64, q);
                osm_update(sc, V + (size_t)kp * 64, m, lsum, O);
            }
        }
    }
    const float inv = 1.0f / lsum;
#pragma unroll
    for (int i = 0; i < 64; ++i) O[i] *= inv;
    store_row64((bf16_t*)(P.ws + OFF_MIX) + (size_t)(b * SEQ + s) * 1024 + h * 64, O);
}

__device__ __forceinline__ void attn_moba_unit(const Params& P, int u) {
    const int lane = opaque_tid() & 63;
    const int c = 127 - u / 12, bh = u % 12, b = bh / 6, hm = bh % 6, h = 10 + hm;
    const int s = c * 64 + lane, own = c >> 2;
    const bf16_t* Q = (const bf16_t*)(P.ws + OFF_Q) + ((size_t)(b * NH + h) * SEQ) * 64;
    const bf16_t* K = (const bf16_t*)(P.ws + OFF_K) + ((size_t)(b * NH + h) * SEQ) * 64;
    const bf16_t* V = (const bf16_t*)(P.ws + OFF_V) + ((size_t)(b * NH + h) * SEQ) * 64;
    const float* KM = (const float*)(P.ws + OFF_KMEAN) + (size_t)((b * 6 + hm) * 32) * 64;
    float q[64]; load_row64(Q + (size_t)s * 64, q);
    float g0 = -INFINITY, g1 = -INFINITY, g2 = -INFINITY; int n0 = -1, n1 = -1, n2 = -1;
#pragma unroll 1
    for (int n = 0; n < own; ++n) {
        float g = 0.f;
#pragma unroll
        for (int i = 0; i < 64; ++i) g += q[i] * KM[n * 64 + i];
        if (g > g0) { g2 = g1; n2 = n1; g1 = g0; n1 = n0; g0 = g; n0 = n; }
        else if (g > g1) { g2 = g1; n2 = n1; g1 = g; n1 = n; }
        else if (g > g2) { g2 = g; n2 = n; }
    }
#pragma unroll
    for (int i = 0; i < 64; ++i) q[i] *= 0.125f;
    float O[64];
#pragma unroll
    for (int i = 0; i < 64; ++i) O[i] = 0.f;
    float m = -1e30f, lsum = 0.f;
    for (int n = 0; n <= own; ++n) {
        const bool selb = (n == own) || (n == n0) || (n == n1) || (n == n2);
        if (__ballot(selb) == 0ull) continue;
        const int jend = (n == own) ? (c * 64 + 63 - n * 256) : 255;
#pragma unroll 1
        for (int jj = 0; jj <= jend; ++jj) {
            const int j = n * 256 + jj;
            const float sc = dotk<8>(K + (size_t)j * 64, q);
            if (selb && j <= s) osm_update(sc, V + (size_t)j * 64, m, lsum, O);
        }
    }
    const float inv = 1.0f / lsum;
#pragma unroll
    for (int i = 0; i < 64; ++i) O[i] *= inv;
    store_row64((bf16_t*)(P.ws + OFF_MIX) + (size_t)(b * SEQ + s) * 1024 + h * 64, O);
}

typedef float f32x16 __attribute__((ext_vector_type(16)));
__device__ __forceinline__ int swap23(int r) { return (r & ~12) | ((r & 4) << 1) | ((r & 8) >> 1); }
constexpr int AT_ROWB = 144, AT_TILEB = 64 * AT_ROWB, AT_BUFB = 2 * AT_TILEB, AT_QWORD = 2 * AT_BUFB;
__device__ __forceinline__ bf16x8 pack8(const f32x16& x, int s) {
    bf16x8 p; unsigned* pu = (unsigned*)&p;
    pu[0] = pack2(x[8 * s], x[8 * s + 1]); pu[1] = pack2(x[8 * s + 2], x[8 * s + 3]); pu[2] = pack2(x[8 * s + 4], x[8 * s + 5]); pu[3] = pack2(x[8 * s + 6], x[8 * s + 7]);
    return p;
}
template <bool FIXED = false>
__device__ __forceinline__ void osm_tile(f32x16 (&x)[2], float sl2, float& m, float& l, f32x16 (&O)[2], bf16x8 (&pf)[2][2], bool en = true) {
    if (FIXED) {
        const float msubf = en ? m : INFINITY;
        float rsf[4] = {0.f, 0.f, 0.f, 0.f};
#pragma unroll
        for (int sub = 0; sub < 2; ++sub)
#pragma unroll
            for (int g = 0; g < 16; ++g) { const float e = fexp2(fmaf(x[sub][g], sl2, -msubf)); x[sub][g] = e; rsf[g & 3] += e; }
        l += (rsf[0] + rsf[1]) + (rsf[2] + rsf[3]);
#pragma unroll
        for (int sub = 0; sub < 2; ++sub) { pf[sub][0] = pack8(x[sub], 0); pf[sub][1] = pack8(x[sub], 1); }
        return;
    }
    float ma = fmaxf(x[0][0], fmaxf(x[0][1], x[0][2])), mb = fmaxf(x[0][8], fmaxf(x[0][9], x[0][10]));
    float mc = fmaxf(x[1][0], fmaxf(x[1][1], x[1][2])), md = fmaxf(x[1][8], fmaxf(x[1][9], x[1][10]));
#pragma unroll
    for (int g = 3; g < 7; g += 2) {
        ma = fmaxf(ma, fmaxf(x[0][g], x[0][g + 1])); mb = fmaxf(mb, fmaxf(x[0][g + 8], x[0][g + 9]));
        mc = fmaxf(mc, fmaxf(x[1][g], x[1][g + 1])); md = fmaxf(md, fmaxf(x[1][g + 8], x[1][g + 9]));
    }
    ma = fmaxf(ma, x[0][7]); mb = fmaxf(mb, x[0][15]); mc = fmaxf(mc, x[1][7]); md = fmaxf(md, x[1][15]);
    float mx = fmaxf(fmaxf(ma, mb), fmaxf(mc, md));
    mx = en ? mx : -INFINITY;
    mx = fmaxf(mx, __shfl_xor(mx, 32));
    const float mxs = mx * sl2;
    if (__ballot(mxs - m > 8.0f) != 0ull) {
        const float mn = fmaxf(m, mxs), alpha = fexp2(m - mn);
        m = mn; l *= alpha;
#pragma unroll
        for (int dt = 0; dt < 2; ++dt)
#pragma unroll
            for (int g = 0; g < 16; ++g) O[dt][g] *= alpha;
    }
    const float msub = en ? m : INFINITY;
    float rs[4] = {0.f, 0.f, 0.f, 0.f};
#pragma unroll
    for (int sub = 0; sub < 2; ++sub)
#pragma unroll
        for (int g = 0; g < 16; ++g) { const float e = fexp2(fmaf(x[sub][g], sl2, -msub)); x[sub][g] = e; rs[g & 3] += e; }
    l += (rs[0] + rs[1]) + (rs[2] + rs[3]);
#pragma unroll
    for (int sub = 0; sub < 2; ++sub) { pf[sub][0] = pack8(x[sub], 0); pf[sub][1] = pack8(x[sub], 1); }
}

__device__ __forceinline__ void osm_fix_sub(f32x16& x, float sl2, float m, float& l, bf16x8 (&pf)[2], bool en = true) {
    const float msub = en ? m : INFINITY;
    float rs[4] = {0.f, 0.f, 0.f, 0.f};
#pragma unroll
    for (int g = 0; g < 16; ++g) { const float e = fexp2(fmaf(x[g], sl2, -msub)); x[g] = e; rs[g & 3] += e; }
    l += (rs[0] + rs[1]) + (rs[2] + rs[3]);
    pf[0] = pack8(x, 0); pf[1] = pack8(x, 1);
}
__device__ __forceinline__ float compute_lam(const Params& P, int l, float lam_init) {
    const int lane = opaque_tid() & 63;
    float a1 = 0.f, a2 = 0.f;
    if (lane < 32) { a1 = P.lq1[l * 32 + lane] * P.lk1[l * 32 + lane]; a2 = P.lq2[l * 32 + lane] * P.lk2[l * 32 + lane]; }
#pragma unroll
    for (int o = 32; o > 0; o >>= 1) { a1 += __shfl_xor(a1, o); a2 += __shfl_xor(a2, o); }
    return expf(a1) - expf(a2) + lam_init;
}
template <int MODE> __device__ __forceinline__ void attn_mfma_unit(const Params& P, unsigned char* lds, int l, int b, int h, int qb) {
    const int tid = opaque_tid(), lane = tid & 63, wid = tid >> 6, r = lane & 31, hh = lane >> 5;
    const size_t bh = (size_t)(b * NH + h);
    const bf16_t* Qg = (const bf16_t*)(P.ws + OFF_Q) + bh * SEQ * 64;
    const bf16_t* Kg = (const bf16_t*)(P.ws + OFF_K) + bh * SEQ * 64;
    const bf16_t* VTg = (const bf16_t*)(P.ws + OFF_V) + (size_t)(b * NVSLOT + (MODE == 0 ? h : h - 6)) * SEQ * 64;
    const int q0 = qb * 256 + wid * 32, sq = q0 + r;
    bf16x8 qf[4];
#pragma unroll
    for (int ks = 0; ks < 4; ++ks) qf[ks] = *(const bf16x8*)(Qg + (size_t)sq * 64 + 16 * ks + 8 * hh);
    int n0 = -1, n1 = -1, n2 = -1;
    if (MODE == 1) {
        const int hm = h - 10, own = qb;
        const float* KM = (const float*)(P.ws + OFF_KMEAN) + (size_t)((b * 6 + hm) * 32) * 64;
        float qv[64]; load_row64(Qg + (size_t)sq * 64, qv);
        float g0 = -INFINITY, g1 = -INFINITY, g2 = -INFINITY;
#pragma unroll 1
        for (int n = 0; n < own; ++n) {
            float g = 0.f;
#pragma unroll
            for (int i = 0; i < 64; ++i) g += qv[i] * KM[n * 64 + i];
            if (g > g0) { g2 = g1; n2 = n1; g1 = g0; n1 = n0; g0 = g; n0 = n; }
            else if (g > g1) { g2 = g1; n2 = n1; g1 = g; n1 = n; }
            else if (g > g2) { g2 = g; n2 = n; }
        }
    }
    const float sl2 = (MODE == 0 ? 0.17677669529663687f : 0.125f) * 1.4426950408889634f;
    f32x16 O1[2], O2[2];
#pragma unroll
    for (int dt = 0; dt < 2; ++dt)
#pragma unroll
        for (int g = 0; g < 16; ++g) { O1[dt][g] = 0.f; O2[dt][g] = 0.f; }
    const float mfix = ((const float*)(P.ws + OFF_SB))[l * 4 + (MODE == 0 ? 0 : 1)];
    float m1 = mfix, l1 = 0.f, l2 = 0.f;
    const int lrow = tid >> 3, lch = tid & 7;
    const bf16_t* kload = Kg + (size_t)lrow * 64 + lch * 8;
    const bf16_t* vload = VTg + (size_t)lrow * SEQ + lch * 8;
    const int lwoff = lrow * AT_ROWB + lch * 16;
    const int ntile = 4 * (qb + 1);
    uint4 kr = *(const uint4*)kload, vr = *(const uint4*)vload;
    __syncthreads();
    *(uint4*)(lds + lwoff) = kr; *(uint4*)(lds + AT_TILEB + lwoff) = vr;
    __syncthreads();
    const int krow_off = swap23(r) * AT_ROWB + hh * 16, vrow_off = r * AT_ROWB + hh * 16;
#pragma unroll 1
    for (int t = 0; t < ntile; ++t) {
        const int k0 = t * 64;
        if (t + 1 < ntile) { kr = *(const uint4*)(kload + (size_t)(k0 + 64) * 64); vr = *(const uint4*)(vload + k0 + 64); }
        bool need = k0 <= q0 + 31;
        bool selb = true;
        if (MODE == 1) { const int n = t >> 2; selb = (n == qb) || (n == n0) || (n == n1) || (n == n2); need = need && (__ballot(selb) != 0ull); }
        if (need) {
            const unsigned char* kb = lds + (t & 1) * AT_BUFB; const unsigned char* vb = kb + AT_TILEB;
            f32x16 xa[2], xb[2];
            bf16x8 kfr[2][4];
#pragma unroll
            for (int sub = 0; sub < 2; ++sub)
#pragma unroll
                for (int ks = 0; ks < 4; ++ks) kfr[sub][ks] = *(const bf16x8*)(kb + sub * 32 * AT_ROWB + krow_off + ks * 32);
            __builtin_amdgcn_sched_barrier(0);
#pragma unroll
            for (int sub = 0; sub < 2; ++sub) {
#pragma unroll
                for (int g = 0; g < 16; ++g) { xa[sub][g] = 0.f; xb[sub][g] = 0.f; }
#pragma unroll
                for (int ks = 0; ks < 4; ++ks) {
                    if (MODE == 0 && ks >= 2) xb[sub] = __builtin_amdgcn_mfma_f32_32x32x16_bf16(kfr[sub][ks], qf[ks], xb[sub], 0, 0, 0);
                    else xa[sub] = __builtin_amdgcn_mfma_f32_32x32x16_bf16(kfr[sub][ks], qf[ks], xa[sub], 0, 0, 0);
                }
            }
            if (k0 + 63 > q0) {
#pragma unroll
                for (int sub = 0; sub < 2; ++sub)
#pragma unroll
                    for (int g = 0; g < 16; ++g) {
                        const int kp = k0 + sub * 32 + (g & 7) + 8 * hh + 16 * (g >> 3);
                        if (kp > sq) { xa[sub][g] = -INFINITY; if (MODE == 0) xb[sub][g] = -INFINITY; }
                    }
            }
            bf16x8 vfr[2][2][2];
#pragma unroll
            for (int dt = 0; dt < 2; ++dt)
#pragma unroll
                for (int sub = 0; sub < 2; ++sub)
#pragma unroll
                    for (int s = 0; s < 2; ++s) vfr[dt][sub][s] = *(const bf16x8*)(vb + dt * 32 * AT_ROWB + vrow_off + (sub * 32 + 16 * s) * 2);
            __builtin_amdgcn_sched_barrier(0);
#pragma unroll
            for (int sub = 0; sub < 2; ++sub) {
                bf16x8 pp[2];
                osm_fix_sub(xa[sub], sl2, m1, l1, pp, selb);
#pragma unroll
                for (int dt = 0; dt < 2; ++dt)
#pragma unroll
                    for (int s = 0; s < 2; ++s) O1[dt] = __builtin_amdgcn_mfma_f32_32x32x16_bf16(vfr[dt][sub][s], pp[s], O1[dt], 0, 0, 0);
                if (MODE == 0) {
                    bf16x8 pq[2];
                    osm_fix_sub(xb[sub], sl2, m1, l2, pq);
#pragma unroll
                    for (int dt = 0; dt < 2; ++dt)
#pragma unroll
                        for (int s = 0; s < 2; ++s) O2[dt] = __builtin_amdgcn_mfma_f32_32x32x16_bf16(vfr[dt][sub][s], pq[s], O2[dt], 0, 0, 0);
                }
            }
        }
        if (t + 1 < ntile) { unsigned char* wb = lds + ((t + 1) & 1) * AT_BUFB; *(uint4*)(wb + lwoff) = kr; *(uint4*)(wb + AT_TILEB + lwoff) = vr; }
        __syncthreads();
    }
    l1 += __shfl_xor(l1, 32);
    bf16_t* dst = (bf16_t*)(P.ws + OFF_MIX) + (size_t)(b * SEQ + sq) * 1024 + h * 64;
    if (MODE == 0) {
        l2 += __shfl_xor(l2, 32);
        int lq = l; asm volatile("" : "+s"(lq));
        const float lam_init = (lq == 0) ? 0.2f : 0.3555090675909693f;
        const float lam = compute_lam(P, l, lam_init);
        const float i1 = 1.0f / l1, i2 = lam / l2;
        float ss = 0.f;
#pragma unroll
        for (int dt = 0; dt < 2; ++dt)
#pragma unroll
            for (int g = 0; g < 16; ++g) { const float v = O1[dt][g] * i1 - O2[dt][g] * i2; O1[dt][g] = v; ss += v * v; }
        ss += __shfl_xor(ss, 32);
        const float rstd = rsqrtf(ss * (1.0f / 64.0f) + EPS) * (1.0f - lam_init);
        const float* gn = P.subln + l * 64;
#pragma unroll
        for (int dt = 0; dt < 2; ++dt)
#pragma unroll
            for (int gq = 0; gq < 4; ++gq) {
                const int d = 32 * dt + 8 * gq + 4 * hh;
                uint2 w; w.x = pack2(O1[dt][4 * gq] * rstd * gn[d], O1[dt][4 * gq + 1] * rstd * gn[d + 1]); w.y = pack2(O1[dt][4 * gq + 2] * rstd * gn[d + 2], O1[dt][4 * gq + 3] * rstd * gn[d + 3]);
                *(uint2*)(dst + d) = w;
            }
    } else {
        const float i1 = 1.0f / l1;
#pragma unroll
        for (int dt = 0; dt < 2; ++dt)
#pragma unroll
            for (int gq = 0; gq < 4; ++gq) {
                const int d = 32 * dt + 8 * gq + 4 * hh;
                uint2 w; w.x = pack2(O1[dt][4 * gq] * i1, O1[dt][4 * gq + 1] * i1); w.y = pack2(O1[dt][4 * gq + 2] * i1, O1[dt][4 * gq + 3] * i1);
                *(uint2*)(dst + d) = w;
            }
    }
}

__device__ __forceinline__ void wave_load(const bf16_t* kp, const bf16_t* vtp, size_t vts32, bf16x8 (&kf)[4], bf16x8 (&vf)[2][2]) {
#pragma unroll
    for (int ks = 0; ks < 4; ++ks) kf[ks] = *(const bf16x8*)(kp + 16 * ks);
#pragma unroll
    for (int dt = 0; dt < 2; ++dt)
#pragma unroll
        for (int s2 = 0; s2 < 2; ++s2) vf[dt][s2] = *(const bf16x8*)(vtp + dt * vts32 + 16 * s2);
}
template <class MaskFn>
__device__ __forceinline__ void wave_compute(const bf16x8 (&kf)[4], const bf16x8 (&vf)[2][2], const bf16x8 (&qf)[4], MaskFn mask, float sl2, float& m, float& l, f32x16 (&O)[2]) {
    f32x16 x;
#pragma unroll
    for (int g = 0; g < 16; ++g) x[g] = 0.f;
#pragma unroll
    for (int ks = 0; ks < 4; ++ks) x = __builtin_amdgcn_mfma_f32_32x32x16_bf16(kf[ks], qf[ks], x, 0, 0, 0);
#pragma unroll
    for (int g = 0; g < 16; ++g) if (!mask(g)) x[g] = -INFINITY;
    float mx = x[0];
#pragma unroll
    for (int g = 1; g < 16; ++g) mx = fmaxf(mx, x[g]);
    mx = fmaxf(mx, __shfl_xor(mx, 32));
    const float mn = fmaxf(m, mx * sl2), alpha = fexp2(m - mn);
    m = mn;
    float rs = 0.f;
#pragma unroll
    for (int g = 0; g < 16; ++g) { const float e = fexp2(fmaf(x[g], sl2, -mn)); x[g] = e; rs += e; }
    l = l * alpha + rs;
    if (__ballot(alpha != 1.0f) != 0ull) {
#pragma unroll
        for (int dt = 0; dt < 2; ++dt)
#pragma unroll
            for (int g = 0; g < 16; ++g) O[dt][g] *= alpha;
    }
    const bf16x8 p0 = pack8(x, 0), p1 = pack8(x, 1);
#pragma unroll
    for (int dt = 0; dt < 2; ++dt) {
        O[dt] = __builtin_amdgcn_mfma_f32_32x32x16_bf16(vf[dt][0], p0, O[dt], 0, 0, 0);
        O[dt] = __builtin_amdgcn_mfma_f32_32x32x16_bf16(vf[dt][1], p1, O[dt], 0, 0, 0);
    }
}
__device__ __forceinline__ void wave_store(bf16_t* dst, const f32x16 (&O)[2], float l, int hh) {
    l += __shfl_xor(l, 32);
    const float inv = 1.0f / l;
#pragma unroll
    for (int dt = 0; dt < 2; ++dt)
#pragma unroll
        for (int gq = 0; gq < 4; ++gq) {
            const int d = 32 * dt + 8 * gq + 4 * hh;
            uint2 w; w.x = pack2(O[dt][4 * gq] * inv, O[dt][4 * gq + 1] * inv); w.y = pack2(O[dt][4 * gq + 2] * inv, O[dt][4 * gq + 3] * inv);
            *(uint2*)(dst + d) = w;
        }
}
__device__ __forceinline__ void attn_dil_mfma(const Params& P, int u) {
    const int lane = opaque_tid() & 63, r = lane & 31, hh = lane >> 5;
    const int gi = u & 15, rho = (u >> 4) & 15, bhd = u >> 8, b = bhd / 6, hd = bhd % 6, h = 4 + hd;
    const size_t bh = (size_t)(b * NH + h);
    const bf16_t* Qg = (const bf16_t*)(P.ws + OFF_Q) + bh * SEQ * 64;
    const bf16_t* Kg = (const bf16_t*)(P.ws + OFF_K) + bh * SEQ * 64;
    const bf16_t* VT = (const bf16_t*)(P.ws + OFF_V) + (size_t)(b * NVSLOT + 10 + hd * 3) * 64 * SEQ;
    const int pos = rho + 16 * (32 * gi + r);
    bf16x8 qf[4];
#pragma unroll
    for (int ks = 0; ks < 4; ++ks) qf[ks] = *(const bf16x8*)(Qg + (size_t)pos * 64 + 16 * ks + 8 * hh);
    f32x16 O[2];
#pragma unroll
    for (int dt = 0; dt < 2; ++dt)
#pragma unroll
        for (int g = 0; g < 16; ++g) O[dt][g] = 0.f;
    float m = -1e30f, l = 0.f;
    const float sl2 = 0.125f * 1.4426950408889634f;
    const int kslot = swap23(r);
    const int t0a = gi == 0 ? 4 : 0, t0c = gi < 4 ? 4 - gi : 0;
    const int na = 20 - t0a, nb = 8 - t0a, ntl = na + nb + 5 - t0c;
    const int r4 = rho & 3;
    auto ptrs = [&](int j, const bf16_t*& kp, const bf16_t*& vtp, int& start, int& mq) {
        if (j < na) { start = 512 * gi - 128 + 32 * (j + t0a); mq = pos; kp = Kg + (size_t)(start + kslot) * 64 + 8 * hh; vtp = VT + (size_t)r * SEQ + start + 8 * hh; }
        else if (j < na + nb) { start = 128 * (gi - 1) + 32 * (j - na + t0a); mq = (rho >> 2) + 128 * gi + 4 * r; kp = Kg + (size_t)((start + kslot) * 4 + r4) * 64 + 8 * hh; vtp = VT + (size_t)64 * SEQ + r4 * 2048 + (size_t)r * SEQ + start + 8 * hh; }
        else { start = 32 * gi - 128 + 32 * (j - na - nb + t0c); mq = 32 * gi + r; kp = Kg + (size_t)((start + kslot) * 16 + rho) * 64 + 8 * hh; vtp = VT + (size_t)128 * SEQ + rho * 512 + (size_t)r * SEQ + start + 8 * hh; }
    };
    bf16x8 kfA[4], vfA[2][2], kfB[4], vfB[2][2];
    int startA, mqA, startB = 0, mqB = 0;
    { const bf16_t* kp; const bf16_t* vtp; ptrs(0, kp, vtp, startA, mqA); wave_load(kp, vtp, (size_t)32 * SEQ, kfA, vfA); }
#pragma unroll 1
    for (int j = 0; j < ntl; j += 2) {
        if (j + 1 < ntl) { const bf16_t* kp; const bf16_t* vtp; ptrs(j + 1, kp, vtp, startB, mqB); wave_load(kp, vtp, (size_t)32 * SEQ, kfB, vfB); }
        wave_compute(kfA, vfA, qf, [&](int g) { const int dl = mqA - (startA + (g & 7) + 8 * hh + 16 * (g >> 3)); return dl >= 0 && dl <= 128; }, sl2, m, l, O);
        if (j + 1 < ntl) {
            if (j + 2 < ntl) { const bf16_t* kp; const bf16_t* vtp; ptrs(j + 2, kp, vtp, startA, mqA); wave_load(kp, vtp, (size_t)32 * SEQ, kfA, vfA); }
            wave_compute(kfB, vfB, qf, [&](int g) { const int dl = mqB - (startB + (g & 7) + 8 * hh + 16 * (g >> 3)); return dl >= 0 && dl <= 128; }, sl2, m, l, O);
        }
    }
    wave_store((bf16_t*)(P.ws + OFF_MIX) + (size_t)(b * SEQ + pos) * 1024 + h * 64, O, l, hh);
}
__device__ __forceinline__ void xattn_mfma_phase(const Params& P) {
    const int tid_ = opaque_tid(), lane = tid_ & 63, r = lane & 31, hh = lane >> 5, gw = blockIdx.x * 8 + (tid_ >> 6);
    const bf16_t* QM = (const bf16_t*)(P.ws + OFF_QM); const bf16_t* KM = (const bf16_t*)(P.ws + OFF_KMEM); const bf16_t* VMT = (const bf16_t*)(P.ws + OFF_VMEM);
    bf16_t* OM = (bf16_t*)(P.ws + OFF_OM);
    const float sl2 = 0.125f * 1.4426950408889634f;
    const int kslot = swap23(r);
    for (int u = gw; u < NTOK / 32 * 4; u += gridDim.x * 8) {
        const int h = u & 3, tok = (u >> 2) * 32 + r, b = tok >> 13;
        bf16x8 qf[4];
#pragma unroll
        for (int ks = 0; ks < 4; ++ks) qf[ks] = *(const bf16x8*)(QM + (size_t)tok * 256 + h * 64 + 16 * ks + 8 * hh);
        f32x16 O[2];
#pragma unroll
        for (int dt = 0; dt < 2; ++dt)
#pragma unroll
            for (int g = 0; g < 16; ++g) O[dt][g] = 0.f;
        float m = -1e30f, l = 0.f;
        const bf16_t* kp0 = KM + (size_t)(b * MEM_LEN + kslot) * 256 + h * 64 + 8 * hh;
        const bf16_t* vtp0 = VMT + ((size_t)(b * 4 + h) * 64 + r) * 256 + 8 * hh;
        bf16x8 kfA[4], vfA[2][2], kfB[4], vfB[2][2];
        wave_load(kp0, vtp0, (size_t)32 * 256, kfA, vfA);
#pragma unroll 1
        for (int tt = 0; tt < 8; tt += 2) {
            wave_load(kp0 + (size_t)(32 * tt + 32) * 256, vtp0 + 32 * tt + 32, (size_t)32 * 256, kfB, vfB);
            wave_compute(kfA, vfA, qf, [](int) { return true; }, sl2, m, l, O);
            if (tt + 2 < 8) wave_load(kp0 + (size_t)(32 * tt + 64) * 256, vtp0 + 32 * tt + 64, (size_t)32 * 256, kfA, vfA);
            wave_compute(kfB, vfB, qf, [](int) { return true; }, sl2, m, l, O);
        }
        wave_store(OM + (size_t)tok * 256 + h * 64, O, l, hh);
    }
}

constexpr size_t PA_REC = 136, OFF_PA0 = OFF_XN, OFF_PA1 = OFF_XN + (size_t)16 * 1024 * 1024;
static_assert((size_t)BATCH * 6 * SEQ * PA_REC <= (size_t)16 * 1024 * 1024, "PA overlay");
template <int BR>
__device__ __forceinline__ void attn_dilwin_unit(const Params& P, unsigned char* lds, int l_, int b, int hd, int res, int qb) {
    constexpr int D = BR == 0 ? 1 : (BR == 1 ? 4 : 16);
    const int tid = opaque_tid(), lane = tid & 63, wid = tid >> 6, r = lane & 31, hh = lane >> 5;
    const int h = 4 + hd;
    const size_t bh = (size_t)(b * NH + h);
    const bf16_t* Qg = (const bf16_t*)(P.ws + OFF_Q) + bh * SEQ * 64;
    const bf16_t* Kg = (const bf16_t*)(P.ws + OFF_K) + bh * SEQ * 64;
    const bf16_t* VTs = (const bf16_t*)(P.ws + OFF_V) + (size_t)(b * NVSLOT + 10 + hd * 3 + BR) * 64 * SEQ + res * (SEQ / D);
    const int q0 = qb * 256 + wid * 32, qi = q0 + r, pos = qi * D + res;
    bf16x8 qf[4];
#pragma unroll
    for (int ks = 0; ks < 4; ++ks) qf[ks] = *(const bf16x8*)(Qg + (size_t)pos * 64 + 16 * ks + 8 * hh);
    const float sl2 = 0.125f * 1.4426950408889634f;
    f32x16 O[2];
#pragma unroll
    for (int dt = 0; dt < 2; ++dt)
#pragma unroll
        for (int g = 0; g < 16; ++g) O[dt][g] = 0.f;
    float m = ((const float*)(P.ws + OFF_SB))[l_ * 4 + 2], l = 0.f;
    const int lrow = tid >> 3, lch = tid & 7;
    const int lwoff = lrow * AT_ROWB + lch * 16;
    const int tlo = qb == 0 ? 0 : 4 * qb - 2, thi = 4 * qb + 3;
    const bf16_t* kload = Kg + ((size_t)lrow * D + res) * 64 + lch * 8;
    const bf16_t* vload = VTs + (size_t)lrow * SEQ + lch * 8;
    uint4 kr = *(const uint4*)(kload + (size_t)tlo * 64 * D * 64), vr = *(const uint4*)(vload + tlo * 64);
    __syncthreads();
    *(uint4*)(lds + (tlo & 1) * AT_BUFB + lwoff) = kr; *(uint4*)(lds + (tlo & 1) * AT_BUFB + AT_TILEB + lwoff) = vr;
    __syncthreads();
    const int krow_off = swap23(r) * AT_ROWB + hh * 16, vrow_off = r * AT_ROWB + hh * 16;
#pragma unroll 1
    for (int t = tlo; t <= thi; ++t) {
        const int k0 = t * 64;
        if (t < thi) { kr = *(const uint4*)(kload + (size_t)(t + 1) * 64 * D * 64); vr = *(const uint4*)(vload + (t + 1) * 64); }
        if (k0 <= q0 + 31 && k0 + 63 >= q0 - 128) {
            const unsigned char* kb = lds + (t & 1) * AT_BUFB; const unsigned char* vb = kb + AT_TILEB;
            f32x16 xa[2];
#pragma unroll
            for (int sub = 0; sub < 2; ++sub) {
#pragma unroll
                for (int g = 0; g < 16; ++g) xa[sub][g] = 0.f;
#pragma unroll
                for (int ks = 0; ks < 4; ++ks) {
                    const bf16x8 kf = *(const bf16x8*)(kb + sub * 32 * AT_ROWB + krow_off + ks * 32);
                    xa[sub] = __builtin_amdgcn_mfma_f32_32x32x16_bf16(kf, qf[ks], xa[sub], 0, 0, 0);
                }
            }
            if (k0 + 63 > q0 || k0 < q0 + 31 - 128) {
#pragma unroll
                for (int sub = 0; sub < 2; ++sub)
#pragma unroll
                    for (int g = 0; g < 16; ++g) {
                        const int dl = qi - (k0 + sub * 32 + (g & 7) + 8 * hh + 16 * (g >> 3));
                        if (dl < 0 || dl > 128) xa[sub][g] = -INFINITY;
                    }
            }
            bf16x8 pa[2][2];
            osm_tile<true>(xa, sl2, m, l, O, pa);
#pragma unroll
            for (int dt = 0; dt < 2; ++dt)
#pragma unroll
                for (int sub = 0; sub < 2; ++sub)
#pragma unroll
                    for (int s2 = 0; s2 < 2; ++s2) {
                        const bf16x8 vf = *(const bf16x8*)(vb + dt * 32 * AT_ROWB + vrow_off + (sub * 32 + 16 * s2) * 2);
                        O[dt] = __builtin_amdgcn_mfma_f32_32x32x16_bf16(vf, pa[sub][s2], O[dt], 0, 0, 0);
                    }
        }
        if (t < thi) { unsigned char* wb = lds + ((t + 1) & 1) * AT_BUFB; *(uint4*)(wb + lwoff) = kr; *(uint4*)(wb + AT_TILEB + lwoff) = vr; }
        __syncthreads();
    }
    l += __shfl_xor(l, 32);
    const size_t rec = ((size_t)(b * 6 + hd) * SEQ + pos) * PA_REC;
    if (BR < 2) {
        unsigned char* pa = P.ws + (BR == 0 ? OFF_PA0 : OFF_PA1) + rec;
#pragma unroll
        for (int dt = 0; dt < 2; ++dt)
#pragma unroll
            for (int gq = 0; gq < 4; ++gq) {
                const int d = 32 * dt + 8 * gq + 4 * hh;
                uint2 w; w.x = pack2(O[dt][4 * gq], O[dt][4 * gq + 1]); w.y = pack2(O[dt][4 * gq + 2], O[dt][4 * gq + 3]);
                *(uint2*)(pa + 2 * d) = w;
            }
        if (hh == 0) { float2 ml; ml.x = m; ml.y = l; *(float2*)(pa + 128) = ml; }
    } else {
        const unsigned char* p0 = P.ws + OFF_PA0 + rec; const unsigned char* p1 = P.ws + OFF_PA1 + rec;
        const float2 ml0 = *(const float2*)(p0 + 128), ml1 = *(const float2*)(p1 + 128);
        const float mm = fmaxf(m, fmaxf(ml0.x, ml1.x));
        const float f0 = fexp2(ml0.x - mm), f1 = fexp2(ml1.x - mm), f2 = fexp2(m - mm);
        const float inv = 1.0f / (ml0.y * f0 + ml1.y * f1 + l * f2);
        bf16_t* dst = (bf16_t*)(P.ws + OFF_MIX) + (size_t)(b * SEQ + pos) * 1024 + h * 64;
#pragma unroll
        for (int dt = 0; dt < 2; ++dt)
#pragma unroll
            for (int gq = 0; gq < 4; ++gq) {
                const int d = 32 * dt + 8 * gq + 4 * hh;
                const uint2 a0 = *(const uint2*)(p0 + 2 * d), a1 = *(const uint2*)(p1 + 2 * d);
                const float o0 = (bflo(a0.x) * f0 + bflo(a1.x) * f1 + O[dt][4 * gq] * f2) * inv, o1 = (bfhi(a0.x) * f0 + bfhi(a1.x) * f1 + O[dt][4 * gq + 1] * f2) * inv;
                const float o2 = (bflo(a0.y) * f0 + bflo(a1.y) * f1 + O[dt][4 * gq + 2] * f2) * inv, o3 = (bfhi(a0.y) * f0 + bfhi(a1.y) * f1 + O[dt][4 * gq + 3] * f2) * inv;
                uint2 w; w.x = pack2(o0, o1); w.y = pack2(o2, o3);
                *(uint2*)(dst + d) = w;
            }
    }
}
__device__ __forceinline__ void dil01_phase(const Params& P, unsigned char* lds, int l_) {
    for (int u = blockIdx.x; u < 768; u += gridDim.x) {
        const int br = u / 384, v = u % 384, bhd = v >> 5, u32 = v & 31, b = bhd / 6, hd = bhd % 6;
        if (br == 0) attn_dilwin_unit<0>(P, lds, l_, b, hd, 0, u32);
        else attn_dilwin_unit<1>(P, lds, l_, b, hd, u32 >> 3, u32 & 7);
    }
}

__device__ __forceinline__ void xattn_block_phase(const Params& P, unsigned char* lds, int l_) {
    const int tid = opaque_tid(), lane = tid & 63, wid = tid >> 6, r = lane & 31, hh = lane >> 5;
    const bf16_t* QM = (const bf16_t*)(P.ws + OFF_QM); const bf16_t* KM = (const bf16_t*)(P.ws + OFF_KMEM); const bf16_t* VMT = (const bf16_t*)(P.ws + OFF_VMEM);
    bf16_t* OM = (bf16_t*)(P.ws + OFF_OM);
    const float sl2 = 0.125f * 1.4426950408889634f;
    const int lrow = tid >> 3, lch = tid & 7, lwoff = lrow * AT_ROWB + lch * 16;
    const int krow_off = swap23(r) * AT_ROWB + hh * 16, vrow_off = r * AT_ROWB + hh * 16;
    for (int u = blockIdx.x; u < (NTOK / 256) * 4; u += gridDim.x) {
        const int h = u & 3, tok = (u >> 2) * 256 + wid * 32 + r, b = (u >> 2) >> 5;
        bf16x8 qf[4];
#pragma unroll
        for (int ks = 0; ks < 4; ++ks) qf[ks] = *(const bf16x8*)(QM + (size_t)tok * 256 + h * 64 + 16 * ks + 8 * hh);
        f32x16 O[2];
#pragma unroll
        for (int dt = 0; dt < 2; ++dt)
#pragma unroll
            for (int g = 0; g < 16; ++g) O[dt][g] = 0.f;
        float m = ((const float*)(P.ws + OFF_SB))[l_ * 4 + 3], l = 0.f;
        const bf16_t* kload = KM + (size_t)(b * MEM_LEN + lrow) * 256 + h * 64 + lch * 8;
        const bf16_t* vload = VMT + ((size_t)(b * 4 + h) * 64 + lrow) * 256 + lch * 8;
        uint4 kr = *(const uint4*)kload, vr = *(const uint4*)vload;
        __syncthreads();
        *(uint4*)(lds + lwoff) = kr; *(uint4*)(lds + AT_TILEB + lwoff) = vr;
        __syncthreads();
#pragma unroll 1
        for (int t = 0; t < 4; ++t) {
            if (t < 3) { kr = *(const uint4*)(kload + (size_t)(t + 1) * 64 * 256); vr = *(const uint4*)(vload + (t + 1) * 64); }
            const unsigned char* kb = lds + (t & 1) * AT_BUFB; const unsigned char* vb = kb + AT_TILEB;
            f32x16 xa[2];
#pragma unroll
            for (int sub = 0; sub < 2; ++sub) {
#pragma unroll
                for (int g = 0; g < 16; ++g) xa[sub][g] = 0.f;
#pragma unroll
                for (int ks = 0; ks < 4; ++ks) {
                    const bf16x8 kf = *(const bf16x8*)(kb + sub * 32 * AT_ROWB + krow_off + ks * 32);
                    xa[sub] = __builtin_amdgcn_mfma_f32_32x32x16_bf16(kf, qf[ks], xa[sub], 0, 0, 0);
                }
            }
            bf16x8 pa[2][2];
            osm_tile<true>(xa, sl2, m, l, O, pa);
#pragma unroll
            for (int dt = 0; dt < 2; ++dt)
#pragma unroll
                for (int sub = 0; sub < 2; ++sub)
#pragma unroll
                    for (int s2 = 0; s2 < 2; ++s2) {
                        const bf16x8 vf = *(const bf16x8*)(vb + dt * 32 * AT_ROWB + vrow_off + (sub * 32 + 16 * s2) * 2);
                        O[dt] = __builtin_amdgcn_mfma_f32_32x32x16_bf16(vf, pa[sub][s2], O[dt], 0, 0, 0);
                    }
            if (t < 3) { unsigned char* wb = lds + ((t + 1) & 1) * AT_BUFB; *(uint4*)(wb + lwoff) = kr; *(uint4*)(wb + AT_TILEB + lwoff) = vr; }
            __syncthreads();
        }
        wave_store(OM + (size_t)tok * 256 + h * 64, O, l, hh);
    }
}

__device__ __forceinline__ void kmean_phase(const Params& P, unsigned char* lds) {
    const int tid = opaque_tid(), cg8 = tid & 7, rg = tid >> 3;
    float* red = (float*)lds;
    for (int u = blockIdx.x; u < 2 * 6 * 32; u += gridDim.x) {
        const int n = u & 31, bh = u >> 5, b = bh / 6, hm = bh % 6;
        const bf16_t* K = (const bf16_t*)(P.ws + OFF_K) + ((size_t)(b * NH + 10 + hm) * SEQ + n * 256) * 64;
        float acc[8];
#pragma unroll
        for (int i = 0; i < 8; ++i) acc[i] = 0.f;
#pragma unroll
        for (int p = 0; p < 4; ++p) {
            const uint4 w = *(const uint4*)(K + (size_t)(rg + 64 * p) * 64 + cg8 * 8);
            acc[0] += bflo(w.x); acc[1] += bfhi(w.x); acc[2] += bflo(w.y); acc[3] += bfhi(w.y); acc[4] += bflo(w.z); acc[5] += bfhi(w.z); acc[6] += bflo(w.w); acc[7] += bfhi(w.w);
        }
        __syncthreads();
#pragma unroll
        for (int i = 0; i < 8; ++i) red[rg * 64 + cg8 * 8 + i] = acc[i];
        __syncthreads();
        if (tid < 64) {
            float sum = 0.f;
            for (int g = 0; g < 64; ++g) sum += red[g * 64 + tid];
            ((float*)(P.ws + OFF_KMEAN))[(size_t)u * 64 + tid] = sum * (1.0f / 256.0f);
        }
    }
}

__device__ __forceinline__ void xattn_phase(const Params& P) {
    const int tid_ = opaque_tid(), lane = tid_ & 63, gw = blockIdx.x * 8 + (tid_ >> 6);
    const bf16_t* QM = (const bf16_t*)(P.ws + OFF_QM); const bf16_t* KM = (const bf16_t*)(P.ws + OFF_KMEM); const bf16_t* VM = (const bf16_t*)(P.ws + OFF_VMEM);
    bf16_t* OM = (bf16_t*)(P.ws + OFF_OM);
    for (int u = gw; u < NTOK * 4 / 64; u += gridDim.x * 8) {
        const int h = u & 3, tok = (u >> 2) * 64 + lane, b = tok >> 13;
        float q[64]; load_row64(QM + (size_t)tok * 256 + h * 64, q);
#pragma unroll
        for (int i = 0; i < 64; ++i) q[i] *= 0.125f;
        float O[64];
#pragma unroll
        for (int i = 0; i < 64; ++i) O[i] = 0.f;
        float m = -1e30f, lsum = 0.f;
#pragma unroll 1
        for (int j = 0; j < MEM_LEN; ++j) {
            const float sc = dotk<8>(KM + (size_t)(b * MEM_LEN + j) * 256 + h * 64, q);
            osm_update(sc, VM + (size_t)(b * MEM_LEN + j) * 256 + h * 64, m, lsum, O);
        }
        const float inv = 1.0f / lsum;
#pragma unroll
        for (int i = 0; i < 64; ++i) O[i] *= inv;
        store_row64(OM + (size_t)tok * 256 + h * 64, O);
    }
}

__device__ const unsigned short kUnitOrder[1024] = {992, 993, 994, 995, 996, 997, 998, 999, 960, 961, 962, 963, 964, 965, 966, 967, 928, 929, 930, 931, 932, 933, 934, 935, 896, 897, 898, 899, 900, 901, 902, 903, 864, 865, 866, 867, 868, 869, 870, 871, 832, 833, 834, 835, 836, 837, 838, 839, 800, 801, 802, 803, 804, 805, 806, 807, 768, 769, 770, 771, 772, 773, 774, 775, 736, 737, 738, 739, 740, 741, 742, 743, 704, 705, 706, 707, 708, 709, 710, 711, 672, 673, 674, 675, 676, 677, 678, 679, 640, 641, 642, 643, 644, 645, 646, 647, 608, 609, 610, 611, 612, 613, 614, 615, 576, 577, 578, 579, 580, 581, 582, 583, 1008, 1009, 1010, 1011, 1012, 1013, 1014, 1015, 1016, 1017, 1018, 1019, 544, 545, 546, 547, 548, 549, 550, 551, 976, 977, 978, 979, 980, 981, 982, 983, 984, 985, 986, 987, 944, 945, 946, 947, 948, 949, 950, 951, 952, 953, 954, 955, 512, 513, 514, 515, 516, 517, 518, 519, 912, 913, 914, 915, 916, 917, 918, 919, 920, 921, 922, 923, 480, 481, 482, 483, 484, 485, 486, 487, 880, 881, 882, 883, 884, 885, 886, 887, 888, 889, 890, 891, 848, 849, 850, 851, 852, 853, 854, 855, 856, 857, 858, 859, 448, 449, 450, 451, 452, 453, 454, 455, 816, 817, 818, 819, 820, 821, 822, 823, 824, 825, 826, 827, 784, 785, 786, 787, 788, 789, 790, 791, 792, 793, 794, 795, 416, 417, 418, 419, 420, 421, 422, 423, 752, 753, 754, 755, 756, 757, 758, 759, 760, 761, 762, 763, 720, 721, 722, 723, 724, 725, 726, 727, 728, 729, 730, 731, 384, 385, 386, 387, 388, 389, 390, 391, 688, 689, 690, 691, 692, 693, 694, 695, 696, 697, 698, 699, 352, 353, 354, 355, 356, 357, 358, 359, 656, 657, 658, 659, 660, 661, 662, 663, 664, 665, 666, 667, 624, 625, 626, 627, 628, 629, 630, 631, 632, 633, 634, 635, 320, 321, 322, 323, 324, 325, 326, 327, 592, 593, 594, 595, 596, 597, 598, 599, 600, 601, 602, 603, 560, 561, 562, 563, 564, 565, 566, 567, 568, 569, 570, 571, 288, 289, 290, 291, 292, 293, 294, 295, 528, 529, 530, 531, 532, 533, 534, 535, 536, 537, 538, 539, 496, 497, 498, 499, 500, 501, 502, 503, 504, 505, 506, 507, 256, 257, 258, 259, 260, 261, 262, 263, 464, 465, 466, 467, 468, 469, 470, 471, 472, 473, 474, 475, 224, 225, 226, 227, 228, 229, 230, 231, 432, 433, 434, 435, 436, 437, 438, 439, 440, 441, 442, 443, 400, 401, 402, 403, 404, 405, 406, 407, 408, 409, 410, 411, 192, 193, 194, 195, 196, 197, 198, 199, 368, 369, 370, 371, 372, 373, 374, 375, 376, 377, 378, 379, 336, 337, 338, 339, 340, 341, 342, 343, 344, 345, 346, 347, 160, 161, 162, 163, 164, 165, 166, 167, 304, 305, 306, 307, 308, 309, 310, 311, 312, 313, 314, 315, 272, 273, 274, 275, 276, 277, 278, 279, 280, 281, 282, 283, 128, 129, 130, 131, 132, 133, 134, 135, 240, 241, 242, 243, 244, 245, 246, 247, 248, 249, 250, 251, 96, 97, 98, 99, 100, 101, 102, 103, 208, 209, 210, 211, 212, 213, 214, 215, 216, 217, 218, 219, 176, 177, 178, 179, 180, 181, 182, 183, 184, 185, 186, 187, 64, 65, 66, 67, 68, 69, 70, 71, 144, 145, 146, 147, 148, 149, 150, 151, 152, 153, 154, 155, 112, 113, 114, 115, 116, 117, 118, 119, 120, 121, 122, 123, 32, 33, 34, 35, 36, 37, 38, 39, 80, 81, 82, 83, 84, 85, 86, 87, 88, 89, 90, 91, 48, 49, 50, 51, 52, 53, 54, 55, 56, 57, 58, 59, 0, 1, 2, 3, 4, 5, 6, 7, 32768, 32769, 32770, 32771, 32772, 32773, 32774, 32775, 32776, 32777, 32778, 32779, 32780, 32781, 32782, 32783, 32784, 32785, 32786, 32787, 32788, 32789, 32790, 32791, 32792, 32793, 32794, 32795, 32796, 32797, 32798, 32799, 32800, 32801, 32802, 32803, 32804, 32805, 32806, 32807, 32808, 32809, 32810, 32811, 32812, 32813, 32814, 32815, 32816, 32817, 32818, 32819, 32820, 32821, 32822, 32823, 32824, 32825, 32826, 32827, 32828, 32829, 32830, 32831, 32832, 32833, 32834, 32835, 32836, 32837, 32838, 32839, 32840, 32841, 32842, 32843, 32844, 32845, 32846, 32847, 32848, 32849, 32850, 32851, 32852, 32853, 32854, 32855, 32856, 32857, 32858, 32859, 32860, 32861, 32862, 32863, 32864, 32865, 32866, 32867, 32868, 32869, 32870, 32871, 32872, 32873, 32874, 32875, 32876, 32877, 32878, 32879, 32880, 32881, 32882, 32883, 32884, 32885, 32886, 32887, 32888, 32889, 32890, 32891, 32892, 32893, 32894, 32895, 32896, 32897, 32898, 32899, 32900, 32901, 32902, 32903, 32904, 32905, 32906, 32907, 32908, 32909, 32910, 32911, 32912, 32913, 32914, 32915, 32916, 32917, 32918, 32919, 32920, 32921, 32922, 32923, 32924, 32925, 32926, 32927, 32928, 32929, 32930, 32931, 32932, 32933, 32934, 32935, 32936, 32937, 32938, 32939, 32940, 32941, 32942, 32943, 32944, 32945, 32946, 32947, 32948, 32949, 32950, 32951, 32952, 32953, 32954, 32955, 32956, 32957, 32958, 32959, 32960, 32961, 32962, 32963, 32964, 32965, 32966, 32967, 32968, 32969, 32970, 32971, 32972, 32973, 32974, 32975, 32976, 32977, 32978, 32979, 32980, 32981, 32982, 32983, 32984, 32985, 32986, 32987, 32988, 32989, 32990, 32991, 32992, 32993, 32994, 32995, 32996, 32997, 32998, 32999, 33000, 33001, 33002, 33003, 33004, 33005, 33006, 33007, 33008, 33009, 33010, 33011, 33012, 33013, 33014, 33015, 33016, 33017, 33018, 33019, 33020, 33021, 33022, 33023, 33024, 33025, 33026, 33027, 33028, 33029, 33030, 33031, 33032, 33033, 33034, 33035, 33036, 33037, 33038, 33039, 33040, 33041, 33042, 33043, 33044, 33045, 33046, 33047, 33048, 33049, 33050, 33051, 33052, 33053, 33054, 33055, 33056, 33057, 33058, 33059, 33060, 33061, 33062, 33063, 33064, 33065, 33066, 33067, 33068, 33069, 33070, 33071, 33072, 33073, 33074, 33075, 33076, 33077, 33078, 33079, 33080, 33081, 33082, 33083, 33084, 33085, 33086, 33087, 33088, 33089, 33090, 33091, 33092, 33093, 33094, 33095, 33096, 33097, 33098, 33099, 33100, 33101, 33102, 33103, 33104, 33105, 33106, 33107, 33108, 33109, 33110, 33111, 33112, 33113, 33114, 33115, 33116, 33117, 33118, 33119, 33120, 33121, 33122, 33123, 33124, 33125, 33126, 33127, 33128, 33129, 33130, 33131, 33132, 33133, 33134, 33135, 33136, 33137, 33138, 33139, 33140, 33141, 33142, 33143, 33144, 33145, 33146, 33147, 33148, 33149, 33150, 33151, 16, 17, 18, 19, 20, 21, 22, 23, 24, 25, 26, 27};
__device__ __forceinline__ void attn_phase(const Params& P, unsigned char* lds, int l, unsigned* ctr) {
    const int tid = opaque_tid();
    constexpr int NUNITS = 1024;
    for (;;) {
        __syncthreads();
        if (tid == 0) *(int*)(lds + AT_QWORD) = (int)atomicAdd(ctr, 1u);
        __syncthreads();
        const int u = *(const int*)(lds + AT_QWORD);
        if (u >= NUNITS) break;
        const int code = kUnitOrder[u];
        if (code & 0x8000) { const int v = code & 0x7fff, bhd = v >> 5, u32 = v & 31; attn_dilwin_unit<2>(P, lds, l, bhd / 6, bhd % 6, u32 >> 1, u32 & 1); }
        else {
            const int qb = code >> 5, j = code & 15;
            if ((code & 16) == 0) attn_mfma_unit<0>(P, lds, l, j >> 2, j & 3, qb);
            else attn_mfma_unit<1>(P, lds, l, j / 6, 10 + j % 6, qb);
        }
    }
}


#define XB_TMO      128
#define XB_XCNT(j)  (256  + 64 * (j))
#define XB_XSUB(j)  (1280 + 64 * (j))
#define XB_XGEN(j)  (2304 + 64 * (j))
#define XB_TOP      3328
#define XB_TOPGEN   3392
#define XCD_BAR_WORDS 3456
#define XB_SPIN_CAP (1u << 18)
#define LAS __attribute__((address_space(3)))

__device__ __forceinline__ unsigned xb_ld(unsigned* p)              { return __hip_atomic_load(p, __ATOMIC_RELAXED, __HIP_MEMORY_SCOPE_AGENT); }
__device__ __forceinline__ unsigned xb_add(unsigned* p, unsigned v) { return __hip_atomic_fetch_add(p, v, __ATOMIC_RELAXED, __HIP_MEMORY_SCOPE_AGENT); }
__device__ __forceinline__ unsigned xb_xcc_id() { return (unsigned)__builtin_amdgcn_s_getreg((3 << 11) | 20) & 0xFu; }
#define XB_SPIN(cond, bar) do { unsigned _sp = 0; while (cond) { __builtin_amdgcn_s_sleep(1); \
    if ((++_sp & 255u) == 0u) { if (xb_ld(&(bar)[XB_TMO])) break; if (_sp > XB_SPIN_CAP) { atomicAdd(&(bar)[XB_TMO], 1u); break; } } } } while (0)

struct XcdBarrier {
    unsigned* bar; unsigned x;
    volatile LAS unsigned* st;
};

__device__ __forceinline__ XcdBarrier xcd_barrier_post(unsigned* bar, volatile LAS unsigned* st) {
    XcdBarrier b; b.bar = bar; b.x = xb_xcc_id(); b.st = st;
    if (threadIdx.x == 0) (void)xb_add(&bar[XB_XCNT(b.x)], 1u);
    return b;
}
__device__ __forceinline__ void xcd_barrier_complete(unsigned* bar, unsigned x, unsigned& nloc, unsigned& nx) {
    const unsigned G = gridDim.x * gridDim.y * gridDim.z;
    unsigned sum, cnt, mine, sp = 0u;
    for (;;) {
        sum = 0u; cnt = 0u; mine = 0u;
#pragma unroll
        for (unsigned j = 0; j < 16; ++j) { const unsigned c = xb_ld(&bar[XB_XCNT(j)]); sum += c; cnt += (c > 0u) ? 1u : 0u; mine = (j == x) ? c : mine; }
        if (sum == G) break;
        __builtin_amdgcn_s_sleep(1);
        if ((++sp & 255u) == 0u) { if (xb_ld(&bar[XB_TMO])) break; if (sp > XB_SPIN_CAP) { atomicAdd(&bar[XB_TMO], 1u); break; } }
    }
    nloc = mine > 0u ? mine : 1u; nx = cnt > 0u ? cnt : 1u;
}

__device__ __forceinline__ void xcd_barrier(const XcdBarrier& b) {
    asm volatile("s_waitcnt vmcnt(0)" ::: "memory");
    __syncthreads();
    if (threadIdx.x == 0) {
        unsigned* bar = b.bar;
        __builtin_amdgcn_s_waitcnt(0);
        unsigned nloc = b.st[0], nx = b.st[1];
        if (nloc == 0u) { xcd_barrier_complete(bar, b.x, nloc, nx); b.st[0] = nloc; b.st[1] = nx; }
        const unsigned old = xb_add(&bar[XB_XSUB(b.x)], 1u);
        const unsigned gen = old / nloc;
        if (old + 1u == (gen + 1u) * nloc) {
            __builtin_amdgcn_fence(__ATOMIC_RELEASE, "agent");
            asm volatile("s_waitcnt vmcnt(0)" ::: "memory");
            const unsigned og = xb_add(&bar[XB_TOP], 1u);
            const unsigned tg = og / nx;
            if (og + 1u == (tg + 1u) * nx) xb_add(&bar[XB_TOPGEN], 1u);
            else XB_SPIN(xb_ld(&bar[XB_TOPGEN]) == tg, bar);
            __builtin_amdgcn_fence(__ATOMIC_ACQUIRE, "agent");
            xb_add(&bar[XB_XGEN(b.x)], 1u);
            asm volatile("s_waitcnt vmcnt(0)" ::: "memory");
        } else {
            XB_SPIN(xb_ld(&bar[XB_XGEN(b.x)]) == gen, bar);
            __builtin_amdgcn_fence(__ATOMIC_ACQUIRE, "agent");
            asm volatile("s_waitcnt vmcnt(0)" ::: "memory");
        }
    }
    __syncthreads();
}

__device__ __forceinline__ void xcd_barrier_at(unsigned char* ws, volatile LAS unsigned* st) {
    XcdBarrier c; c.bar = (unsigned*)(ws + OFF_BAR); c.st = st; c.x = (unsigned)__builtin_amdgcn_readfirstlane((int)st[2]);
    xcd_barrier(c);
}
__device__ __forceinline__ int wmap(int map, int j) {
    if (map == 1) { const int c = j & 255; return (j & ~255) + 64 * ((c >> 5) & 3) + 32 * (c >> 7) + (c & 31); }
    if (map == 2) { const int t = j >> 8, c = j & 255; return c < 128 ? 128 * t + c : D_FF + 128 * t + (c - 128); }
    return j;
}
__device__ __forceinline__ void convert_weight(unsigned char* lds, const float* __restrict__ src, int ldw, int K, int N, bf16_t* __restrict__ dst, int map, int col0, int rot, const float* __restrict__ gk) {
    const int tid = opaque_tid();
    bf16_t* tile = (bf16_t*)lds;
    const int tk = K / 128, ntiles = (N / 64) * tk;
    const int kk = tid >> 4, n4 = (tid & 15) * 4, jr = tid >> 4, k8 = (tid & 15) * 8;
    int t = (int)((blockIdx.x + gridDim.x - (unsigned)rot % gridDim.x) % gridDim.x);
    float4 v[4];
    if (t < ntiles) {
        const int j0 = (t / tk) * 64, k0 = (t % tk) * 128, sc = col0 + wmap(map, j0 + (n4 & 32)) + (n4 & 31);
#pragma unroll
        for (int p = 0; p < 4; ++p) v[p] = *(const float4*)(src + (size_t)(k0 + p * 32 + kk) * ldw + sc);
    }
    for (; t < ntiles; t += gridDim.x) {
        const int j0 = (t / tk) * 64, k0 = (t % tk) * 128;
        __syncthreads();
#pragma unroll
        for (int p = 0; p < 4; ++p) {
            const float g = gk ? gk[k0 + p * 32 + kk] : 1.0f;
            tile[(n4 + 0) * 136 + p * 32 + kk] = f2bf(v[p].x * g); tile[(n4 + 1) * 136 + p * 32 + kk] = f2bf(v[p].y * g); tile[(n4 + 2) * 136 + p * 32 + kk] = f2bf(v[p].z * g); tile[(n4 + 3) * 136 + p * 32 + kk] = f2bf(v[p].w * g);
        }
        const int tn = t + gridDim.x;
        if (tn < ntiles) {
            const int j0n = (tn / tk) * 64, k0n = (tn % tk) * 128, sc = col0 + wmap(map, j0n + (n4 & 32)) + (n4 & 31);
#pragma unroll
            for (int p = 0; p < 4; ++p) v[p] = *(const float4*)(src + (size_t)(k0n + p * 32 + kk) * ldw + sc);
        }
        __syncthreads();
#pragma unroll
        for (int q = 0; q < 2; ++q) *(uint4*)(dst + (size_t)(j0 + jr + 32 * q) * K + k0 + k8) = *(const uint4*)(tile + (jr + 32 * q) * 136 + k8);
    }
}
__device__ __forceinline__ void xb_rows(const float* __restrict__ X, bf16_t* __restrict__ xb, float* __restrict__ part, int nrows) {
    const int tid_ = opaque_tid(), lane = tid_ & 63, wid = tid_ >> 6;
    for (int row = blockIdx.x * 8 + wid; row < nrows; row += gridDim.x * 8) {
        const float4* xp = (const float4*)(X + (size_t)row * 1024);
        float ss = 0.f;
#pragma unroll
        for (int i = 0; i < 4; ++i) {
            const float4 v = xp[lane + 64 * i]; ss += v.x * v.x + v.y * v.y + v.z * v.z + v.w * v.w;
            uint2 w; w.x = pack2(v.x, v.y); w.y = pack2(v.z, v.w);
            *(uint2*)(xb + (size_t)row * 1024 + (lane + 64 * i) * 4) = w;
        }
#pragma unroll
        for (int o = 32; o > 0; o >>= 1) ss += __shfl_xor(ss, o);
        if (lane < 16) part[(size_t)row * 16 + lane] = lane == 0 ? ss : 0.f;
    }
}
__device__ __forceinline__ void prologue_phase(const Params& P, unsigned char* lds) {
    int rot = 0;
    for (int l = 0; l < DEPTH; ++l) {
        bf16_t* wb = (bf16_t*)(P.ws + OFF_WB) + (size_t)l * WB_LAYER;
        convert_weight(lds, P.w_in + (size_t)l * 1024 * 3072, 3072, 1024, 2048, wb + WB_IN, 1, 0, rot, P.norm_mix + l * 1024); rot += 256;
        convert_weight(lds, P.w_in + (size_t)l * 1024 * 3072, 3072, 1024, 1024, wb + WB_IN + (size_t)2048 * 1024, 0, 2048, rot, P.norm_mix + l * 1024); rot += 128;
        convert_weight(lds, P.w_out + (size_t)l * 1024 * 1024, 1024, 1024, 1024, wb + WB_OUT, 0, 0, rot, nullptr); rot += 128;
        convert_weight(lds, P.w_mq + (size_t)l * 1024 * 256, 256, 1024, 256, wb + WB_MQ, 1, 0, rot, P.norm_cross + l * 1024); rot += 32;
        convert_weight(lds, P.w_mkv + (size_t)l * 1024 * 512, 512, 1024, 512, wb + WB_MKV, 1, 0, rot, nullptr); rot += 64;
        convert_weight(lds, P.w_mo + (size_t)l * 256 * 1024, 1024, 256, 1024, wb + WB_MO, 0, 0, rot, nullptr); rot += 32;
        convert_weight(lds, P.w_gu + (size_t)l * 1024 * 5632, 5632, 1024, 5632, wb + WB_GU, 2, 0, rot, P.norm_ffn + l * 1024); rot += 704;
        convert_weight(lds, P.w_down + (size_t)l * 2816 * 1024, 1024, 2816, 1024, wb + WB_DOWN, 0, 0, rot, nullptr); rot += 352;
        norm_rows(P.mem, P.norm_mem + l * 1024, (bf16_t*)(P.ws + OFF_MEMN) + (size_t)l * 512 * 1024, BATCH * MEM_LEN);
    }
    xb_rows(P.x, (bf16_t*)(P.ws + OFF_XN), (float*)(P.ws + OFF_PART), NTOK);
    float* cs = (float*)(P.ws + OFF_CS);
    for (int i = blockIdx.x * NTHREADS + opaque_tid(); i < NTOK * 8; i += gridDim.x * NTHREADS) {
        const int tok = i >> 3, f = i & 7;
        const float invf = (f == 0) ? 1.0f : (f == 1) ? 0.19392547244381735f : (f == 2) ? 0.037606030930863934f : (f == 3) ? 0.007292767314834156f :
                           (f == 4) ? 0.0014142135623730951f : (f == 5) ? 0.0002742520333386866f : (f == 6) ? 5.318295896944989e-05f : 1.0313530666425395e-05f;
        const float ang = (float)P.pos[tok] * invf;
        cs[2 * i] = cosf(ang); cs[2 * i + 1] = sinf(ang);
    }
}

__global__ void __launch_bounds__(NTHREADS) fwd_megakernel(Params P) {
    extern __shared__ __attribute__((aligned(16))) unsigned char lds[];
    cg::grid_group grid = cg::this_grid();
    unsigned* ctrl = (unsigned*)(P.ws + OFF_CTRL);
    bf16_t* XN = (bf16_t*)(P.ws + OFF_XN);
    if (blockIdx.x == 0 && threadIdx.x < 8) {
        const int l = threadIdx.x >> 2, ty = threadIdx.x & 3, n = ty == 0 ? 32 : 64;
        const float* gq = ty == 0 ? P.qn_diff + l * 32 : ty == 1 ? P.qn_moba + l * 64 : ty == 2 ? P.qn_dil + l * 64 : P.qn_mem + l * 64;
        const float* gk = ty == 0 ? P.kn_diff + l * 32 : ty == 1 ? P.kn_moba + l * 64 : ty == 2 ? P.kn_dil + l * 64 : P.kn_mem + l * 64;
        float a = 0.f, b = 0.f;
        for (int i = 0; i < n; ++i) { a = fmaxf(a, fabsf(gq[i])); b = fmaxf(b, fabsf(gk[i])); }
        ((float*)(P.ws + OFF_SB))[threadIdx.x] = a * b * (float)n * (ty == 0 ? 0.17677669529663687f : 0.125f) * 1.4426950408889634f * 1.02f;
    }
    if (blockIdx.x == 0) {
        float* gt = (float*)(P.ws + OFF_GT);
        for (int i = threadIdx.x; i < 768; i += NTHREADS) {
            const int d = i & 63, ty = (i >> 6) % 3, wh = (i / 192) & 1, l = i / 384;
            float v = 0.f;
            if (ty == 0) { if (d < 32) v = (wh == 0 ? P.qn_diff : P.kn_diff)[l * 32 + d]; }
            else if (ty == 1) v = (wh == 0 ? P.qn_dil : P.kn_dil)[l * 64 + d];
            else v = (wh == 0 ? P.qn_moba : P.kn_moba)[l * 64 + d];
            gt[i] = v;
        }
    }
    volatile LAS unsigned* xbst = (volatile LAS unsigned*)((LAS unsigned char*)lds + 131072 + 64);
    if (threadIdx.x < 4) xbst[threadIdx.x] = 0u;
    __syncthreads();
    { XcdBarrier xb0 = xcd_barrier_post((unsigned*)(P.ws + OFF_BAR), xbst); if (threadIdx.x == 0) xbst[2] = xb0.x; }
    __syncthreads();
    prologue_phase(P, lds);
    if (P.ws == nullptr) grid.sync();
    xcd_barrier_at(P.ws, xbst);
    const float* PART = (const float*)(P.ws + OFF_PART);
    PG8_LAS unsigned char* glds = (PG8_LAS unsigned char*)lds;
    const int G = (int)gridDim.x, bx = (int)blockIdx.x;
    for (int l = 0; l < DEPTH; ++l) {
        const float* xin = (l == 0) ? P.x : P.out;
        const bf16_t* wb = (const bf16_t*)(P.ws + OFF_WB) + (size_t)l * WB_LAYER;
        {
            pg8::Gemm g{XN, wb + WB_IN, NTOK, 2048, 1024}; pg8::StaticOrder S; S.init(NTOK, 2048, G, bx);
            pg8::EpiQK e{(const float*)(P.ws + OFF_GT) + l * 384, (const float*)(P.ws + OFF_CS), (bf16_t*)(P.ws + OFF_Q), PART};
            pg8::gemm_phase<pg8::EpiQK, pg8::StaticOrder, true, true>(glds, g, S, e);
            pg8::Gemm g2{wb + WB_IN + (size_t)2048 * 1024, XN, 1024, NTOK, 1024}; pg8::StaticOrder S2; S2.init(1024, NTOK, G, bx);
            pg8::EpiVT e2{(bf16_t*)(P.ws + OFF_V), PART};
            pg8::gemm_phase<pg8::EpiVT, pg8::StaticOrder, true, true>(glds, g2, S2, e2);
        }
        xcd_barrier_at(P.ws, xbst);
        kmean_phase(P, lds);
        dil01_phase(P, lds, l);
        xcd_barrier_at(P.ws, xbst);
        attn_phase(P, lds, l, ctrl + 16 * l);
        xcd_barrier_at(P.ws, xbst);
        {
            pg8::Gemm g{(const bf16_t*)(P.ws + OFF_MIX), wb + WB_OUT, NTOK, 1024, 1024}; pg8::StaticOrder S; S.init(NTOK, 1024, G, bx);
            pg8::EpiResid2 e{xin, P.out, XN, (float*)(P.ws + OFF_PART)};
            pg8::gemm_phase<pg8::EpiResid2, pg8::StaticOrder, true, true>(glds, g, S, e);
        }
        xcd_barrier_at(P.ws, xbst);
        {
            pg8::Gemm g{XN, wb + WB_MQ, NTOK, 256, 1024}; pg8::StaticOrder S; S.init(NTOK, 256, G, bx);
            pg8::EpiHead2 e{P.qn_mem + l * 64, (bf16_t*)(P.ws + OFF_QM), nullptr, PART};
            pg8::gemm_phase<pg8::EpiHead2, pg8::StaticOrder, true, true>(glds, g, S, e);
            pg8::Gemm g2{(const bf16_t*)(P.ws + OFF_MEMN) + (size_t)l * 512 * 1024, wb + WB_MKV, 512, 512, 1024}; pg8::StaticOrder S2; S2.init(512, 512, G, (bx + G - 64) % G);
            pg8::EpiHead2 e2{P.kn_mem + l * 64, (bf16_t*)(P.ws + OFF_KMEM), (bf16_t*)(P.ws + OFF_VMEM), nullptr};
            pg8::gemm_phase<pg8::EpiHead2, pg8::StaticOrder, true, true>(glds, g2, S2, e2);
        }
        xcd_barrier_at(P.ws, xbst);
        xattn_block_phase(P, lds, l);
        xcd_barrier_at(P.ws, xbst);
        {
            pg8::Gemm g{(const bf16_t*)(P.ws + OFF_OM), wb + WB_MO, NTOK, 1024, 256}; pg8::StaticOrder S; S.init(NTOK, 1024, G, bx);
            pg8::EpiResid2 e{P.out, P.out, XN, (float*)(P.ws + OFF_PART)};
            pg8::gemm_phase<pg8::EpiResid2, pg8::StaticOrder, true, true>(glds, g, S, e);
        }
        xcd_barrier_at(P.ws, xbst);
        {
            pg8::Gemm g{XN, wb + WB_GU, NTOK, 2 * D_FF, 1024}; pg8::StaticOrder S; S.init(NTOK, 2 * D_FF, G, bx);
            pg8::EpiSwiglu2 e{(bf16_t*)(P.ws + OFF_H), PART};
            pg8::gemm_phase<pg8::EpiSwiglu2, pg8::StaticOrder, true, true>(glds, g, S, e);
        }
        xcd_barrier_at(P.ws, xbst);
        {
            pg8::Gemm g{(const bf16_t*)(P.ws + OFF_H), wb + WB_DOWN, NTOK, 1024, D_FF}; pg8::StaticOrder S; S.init(NTOK, 1024, G, bx);
            pg8::EpiResid2 e{P.out, P.out, (l + 1 < DEPTH) ? XN : nullptr, (float*)(P.ws + OFF_PART)};
            pg8::gemm_phase<pg8::EpiResid2, pg8::StaticOrder, true, true>(glds, g, S, e);
        }
        xcd_barrier_at(P.ws, xbst);
    }
}

extern "C" void kernel_launch(void* const* d_in, const int* in_sizes, int n_in, void* d_out, int out_size, void* d_ws, size_t ws_size, hipStream_t stream) {
    static int grid_blocks = 0;
    if (!grid_blocks) {
        int dev = 0, cus = 0, per_cu = 0;
        hipGetDevice(&dev);
        hipDeviceGetAttribute(&cus, hipDeviceAttributeMultiprocessorCount, dev);
        hipFuncSetAttribute((const void*)fwd_megakernel, hipFuncAttributeMaxDynamicSharedMemorySize, LDS_BYTES);
        hipOccupancyMaxActiveBlocksPerMultiprocessor(&per_cu, fwd_megakernel, NTHREADS, LDS_BYTES);
        if (per_cu < 1) per_cu = 1;
        if (per_cu > 1) per_cu = 1;
        grid_blocks = cus * per_cu;
    }
    Params p{};
    p.x = (const float*)d_in[0]; p.mem = (const float*)d_in[1]; p.pos = (const int*)d_in[2];
    p.norm_mix = (const float*)d_in[3]; p.w_in = (const float*)d_in[4]; p.qn_diff = (const float*)d_in[5]; p.kn_diff = (const float*)d_in[6];
    p.lq1 = (const float*)d_in[7]; p.lk1 = (const float*)d_in[8]; p.lq2 = (const float*)d_in[9]; p.lk2 = (const float*)d_in[10]; p.subln = (const float*)d_in[11];
    p.qn_dil = (const float*)d_in[12]; p.kn_dil = (const float*)d_in[13]; p.qn_moba = (const float*)d_in[14]; p.kn_moba = (const float*)d_in[15]; p.w_out = (const float*)d_in[16];
    p.norm_cross = (const float*)d_in[17]; p.norm_mem = (const float*)d_in[18]; p.w_mq = (const float*)d_in[19]; p.w_mkv = (const float*)d_in[20];
    p.qn_mem = (const float*)d_in[21]; p.kn_mem = (const float*)d_in[22]; p.w_mo = (const float*)d_in[23]; p.norm_ffn = (const float*)d_in[24];
    p.w_gu = (const float*)d_in[25]; p.w_down = (const float*)d_in[26];
    p.out = (float*)d_out; p.ws = (unsigned char*)d_ws;
    hipMemsetAsync(d_ws, 0, 32768, stream);
    void* args[] = {&p};
    hipError_t e = hipLaunchCooperativeKernel((const void*)fwd_megakernel, dim3(grid_blocks), dim3(NTHREADS), args, LDS_BYTES, stream);
    if (e != hipSuccess) fprintf(stderr, "cooperative launch failed: %s (grid %d)\n", hipGetErrorString(e), grid_blocks);
}
```

```cpp
#include <hip/hip_runtime.h>
#include <hip/hip_cooperative_groups.h>
#include <cstdio>
#include <cstdint>
namespace cg = cooperative_groups;

typedef unsigned short bf16_t;
typedef short bf16x8 __attribute__((ext_vector_type(8)));
typedef float f32x4 __attribute__((ext_vector_type(4)));

constexpr int D_MODEL = 1024, BATCH = 2, SEQ = 8192, DEPTH = 2, NTOK = BATCH * SEQ;
constexpr int NH = 16, HD = 64, D_FF = 2816, MEM_LEN = 256, MEMW = 256;
constexpr float EPS = 1e-6f;
constexpr int NTHREADS = 512;
constexpr int LDS_BYTES = 131072 + 256;

struct Params {
    const float* x; const float* mem; const int* pos;
    const float* norm_mix; const float* w_in; const float* qn_diff; const float* kn_diff;
    const float* lq1; const float* lk1; const float* lq2; const float* lk2; const float* subln;
    const float* qn_dil; const float* kn_dil; const float* qn_moba; const float* kn_moba; const float* w_out;
    const float* norm_cross; const float* norm_mem; const float* w_mq; const float* w_mkv;
    const float* qn_mem; const float* kn_mem; const float* w_mo; const float* norm_ffn;
    const float* w_gu; const float* w_down;
    float* out; unsigned char* ws;
};

constexpr size_t OFF_CTRL = 0;
constexpr size_t OFF_BAR  = 4096;
constexpr size_t OFF_XN   = 32768;
constexpr size_t OFF_MIX  = OFF_XN + (size_t)NTOK * 1024 * 2;
constexpr size_t OFF_PART = OFF_MIX + (size_t)NTOK * 1024 * 2;
constexpr size_t OFF_Q0   = OFF_PART + (size_t)NTOK * 16 * 4;
constexpr size_t OFF_Q    = OFF_Q0;
constexpr size_t OFF_K    = OFF_Q + (size_t)NTOK * 1024 * 2;
constexpr size_t OFF_V    = OFF_K + (size_t)NTOK * 1024 * 2;
constexpr int    NVSLOT   = 28;
constexpr size_t OFF_H    = OFF_Q;
constexpr size_t OFF_QM   = OFF_Q;
constexpr size_t OFF_OM   = OFF_K;
constexpr size_t OFF_MEMN = OFF_V + (size_t)BATCH * NVSLOT * 64 * SEQ * 2;
constexpr size_t OFF_KMEM = OFF_MEMN + (size_t)2 * 512 * 1024 * 2;
constexpr size_t OFF_VMEM = OFF_KMEM + (size_t)512 * 256 * 2;
constexpr size_t OFF_KMEAN= OFF_VMEM + (size_t)512 * 256 * 2;
constexpr size_t OFF_GT   = OFF_KMEAN + (size_t)2 * 6 * 32 * 64 * 4;
constexpr size_t OFF_SB   = OFF_GT + 2 * 2 * 3 * 64 * 4;
constexpr size_t OFF_CS   = OFF_SB + 256;
constexpr size_t OFF_WB   = OFF_CS + (size_t)NTOK * 16 * 4;
constexpr size_t WB_IN = 0, WB_OUT = WB_IN + (size_t)3072 * 1024, WB_MQ = WB_OUT + (size_t)1024 * 1024, WB_MKV = WB_MQ + (size_t)256 * 1024, WB_MO = WB_MKV + (size_t)512 * 1024,
                 WB_GU = WB_MO + (size_t)1024 * 256, WB_DOWN = WB_GU + (size_t)5632 * 1024, WB_LAYER = WB_DOWN + (size_t)1024 * 2816;
constexpr size_t WS_END   = OFF_WB + 2 * WB_LAYER * 2;
static_assert((size_t)NTOK * 2816 * 2 <= OFF_MEMN - OFF_Q, "h overlay");
static_assert(WS_END <= (size_t)268435456, "workspace");

__device__ __forceinline__ bf16_t f2bf(float f) { unsigned u = __float_as_uint(f); u += 0x7fffu + ((u >> 16) & 1u); return (bf16_t)(u >> 16); }
__device__ __forceinline__ float bf2f(bf16_t h) { return __uint_as_float(((unsigned)h) << 16); }
__device__ __forceinline__ float bflo(unsigned w) { return __uint_as_float(w << 16); }
__device__ __forceinline__ float bfhi(unsigned w) { return __uint_as_float(w & 0xffff0000u); }
typedef float f32x2c __attribute__((ext_vector_type(2)));
typedef __bf16 bf16x2c __attribute__((ext_vector_type(2)));
__device__ __forceinline__ unsigned pack2(float a, float b) { const f32x2c v = {a, b}; return __builtin_bit_cast(unsigned, __builtin_convertvector(v, bf16x2c)); }
__device__ __forceinline__ float fexp2(float x) { return __builtin_amdgcn_exp2f(x); }

__device__ __forceinline__ int opaque_tid() { int t = threadIdx.x; asm volatile("" : "+v"(t)); return t; }
__device__ __forceinline__ void norm_rows(const float* __restrict__ X, const float* __restrict__ g, bf16_t* __restrict__ out, int nrows) {
    const int tid_ = opaque_tid(), lane = tid_ & 63, wid = tid_ >> 6;
    for (int row = blockIdx.x * 8 + wid; row < nrows; row += gridDim.x * 8) {
        const float4* xp = (const float4*)(X + (size_t)row * 1024);
        float4 v[4]; float ss = 0.f;
#pragma unroll
        for (int i = 0; i < 4; ++i) { v[i] = xp[lane + 64 * i]; ss += v[i].x * v[i].x + v[i].y * v[i].y + v[i].z * v[i].z + v[i].w * v[i].w; }
#pragma unroll
        for (int o = 32; o > 0; o >>= 1) ss += __shfl_xor(ss, o);
        const float rstd = rsqrtf(ss * (1.0f / 1024.0f) + EPS);
#pragma unroll
        for (int i = 0; i < 4; ++i) {
            const float4 gg = ((const float4*)g)[lane + 64 * i];
            uint2 w; w.x = pack2(v[i].x * rstd * gg.x, v[i].y * rstd * gg.y); w.y = pack2(v[i].z * rstd * gg.z, v[i].w * rstd * gg.w);
            *(uint2*)(out + (size_t)row * 1024 + (lane + 64 * i) * 4) = w;
        }
    }
}

struct CmId { __device__ __forceinline__ int operator()(int c) const { return c; } };
struct CmGU { __device__ __forceinline__ int operator()(int c) const { const int t = c >> 7, w = c & 127; return w < 64 ? (64 * t + w) : (D_FF + 64 * t + (w - 64)); } };

template <class CM, class Epi>
__device__ __forceinline__ void gemm_run(unsigned char* lds, const bf16_t* __restrict__ A, int lda, const float* __restrict__ W, int ldw, int K, int mt, int nt, int first, CM cm, Epi epi) {
    const int tid = opaque_tid(), lane = tid & 63, wid = tid >> 6, wr = wid >> 1, wc = wid & 1, fr = lane & 15, fq = lane >> 4;
    bf16_t* sA = (bf16_t*)lds;
    bf16_t* sB = sA + 128 * 40;
    float* sC = (float*)lds;
    const int ntiles = mt * nt;
    const int arow = tid >> 2, akc = (tid & 3) * 8, bk = tid >> 4, bn8 = (tid & 15) * 8;
    for (int tile = first; tile < ntiles; tile += gridDim.x) {
        const int tm = tile / nt, tn = tile % nt, m0 = tm * 128, n0 = tn * 128;
        f32x4 acc[2][4];
#pragma unroll
        for (int m = 0; m < 2; ++m)
#pragma unroll
            for (int n = 0; n < 4; ++n) acc[m][n] = (f32x4){0.f, 0.f, 0.f, 0.f};
        const bf16_t* ap = A + (size_t)(m0 + arow) * lda + akc;
        const float* bp = W + (size_t)bk * ldw + cm(n0 + bn8);
        uint4 ra = *(const uint4*)ap; float4 rb0 = *(const float4*)bp, rb1 = *(const float4*)(bp + 4);
        const int nk = K / 32;
        for (int kt = 0; kt < nk; ++kt) {
            __syncthreads();
            *(uint4*)(sA + arow * 40 + akc) = ra;
            sB[(bn8 + 0) * 40 + bk] = f2bf(rb0.x); sB[(bn8 + 1) * 40 + bk] = f2bf(rb0.y); sB[(bn8 + 2) * 40 + bk] = f2bf(rb0.z); sB[(bn8 + 3) * 40 + bk] = f2bf(rb0.w);
            sB[(bn8 + 4) * 40 + bk] = f2bf(rb1.x); sB[(bn8 + 5) * 40 + bk] = f2bf(rb1.y); sB[(bn8 + 6) * 40 + bk] = f2bf(rb1.z); sB[(bn8 + 7) * 40 + bk] = f2bf(rb1.w);
            __syncthreads();
            if (kt + 1 < nk) { ap += 32; bp += (size_t)32 * ldw; ra = *(const uint4*)ap; rb0 = *(const float4*)bp; rb1 = *(const float4*)(bp + 4); }
            bf16x8 af[2], bfr[4];
#pragma unroll
            for (int m = 0; m < 2; ++m) af[m] = *(const bf16x8*)(sA + (wr * 32 + m * 16 + fr) * 40 + fq * 8);
#pragma unroll
            for (int n = 0; n < 4; ++n) bfr[n] = *(const bf16x8*)(sB + (wc * 64 + n * 16 + fr) * 40 + fq * 8);
#pragma unroll
            for (int m = 0; m < 2; ++m)
#pragma unroll
                for (int n = 0; n < 4; ++n) acc[m][n] = __builtin_amdgcn_mfma_f32_16x16x32_bf16(af[m], bfr[n], acc[m][n], 0, 0, 0);
        }
        __syncthreads();
#pragma unroll
        for (int m = 0; m < 2; ++m)
#pragma unroll
            for (int n = 0; n < 4; ++n)
#pragma unroll
                for (int j = 0; j < 4; ++j) sC[(wr * 32 + m * 16 + fq * 4 + j) * 132 + wc * 64 + n * 16 + fr] = acc[m][n][j];
        __syncthreads();
        epi(tm, tn, sC, tid);
    }
    __syncthreads();
}

struct EpiResid {
    const float* src; float* out;
    __device__ __forceinline__ void operator()(int tm, int tn, const float* sC, int tid) const {
        const int row = tid >> 2, c0 = (tid & 3) * 32;
        const size_t off = (size_t)(tm * 128 + row) * 1024 + tn * 128 + c0;
#pragma unroll
        for (int i = 0; i < 8; ++i) {
            const float4 s = *(const float4*)(src + off + i * 4); const float4 c = *(const float4*)(sC + row * 132 + c0 + i * 4);
            float4 o; o.x = s.x + c.x; o.y = s.y + c.y; o.z = s.z + c.z; o.w = s.w + c.w; *(float4*)(out + off + i * 4) = o;
        }
    }
};
struct EpiQKV {
    const int* pos; const float* gt;
    bf16_t* q;
    __device__ __forceinline__ void operator()(int tm, int tn, const float* sC, int tid) const {
        const int which = tn >> 3;
        if (which == 2) {
            const int col = tid & 127, tg = tid >> 7, hd = (tn & 7) * 2 + (col >> 6), d = col & 63;
            const int tok0 = tm * 128 + tg * 32, bb = tok0 >> 13, s0 = tok0 & 8191;
            bf16_t* vt = q + (size_t)2 * ((size_t)NTOK * 1024);
            const float* c = sC + (tg * 32) * 132 + col;
            const int ht = tn & 7;
            const int slot = ht < 2 ? hd : (ht >= 5 ? hd - 6 : 10 + (hd - 4) * 3);
            bf16_t* dstv = vt + ((size_t)(bb * NVSLOT + slot) * 64 + d) * SEQ;
#pragma unroll
            for (int i = 0; i < 4; ++i) {
                uint4 w; w.x = pack2(c[(8 * i) * 132], c[(8 * i + 1) * 132]); w.y = pack2(c[(8 * i + 2) * 132], c[(8 * i + 3) * 132]); w.z = pack2(c[(8 * i + 4) * 132], c[(8 * i + 5) * 132]); w.w = pack2(c[(8 * i + 6) * 132], c[(8 * i + 7) * 132]);
                *(uint4*)(dstv + s0 + i * 8) = w;
            }
            if (ht >= 2 && ht < 5) {
                bf16_t* d4 = dstv + (size_t)64 * SEQ; bf16_t* d16 = dstv + (size_t)2 * 64 * SEQ;
#pragma unroll
                for (int res = 0; res < 4; ++res) {
                    uint4 w; w.x = pack2(c[(res) * 132], c[(res + 4) * 132]); w.y = pack2(c[(res + 8) * 132], c[(res + 12) * 132]); w.z = pack2(c[(res + 16) * 132], c[(res + 20) * 132]); w.w = pack2(c[(res + 24) * 132], c[(res + 28) * 132]);
                    *(uint4*)(d4 + res * 2048 + (s0 >> 2)) = w;
                }
#pragma unroll
                for (int res = 0; res < 16; ++res) *(unsigned*)(d16 + res * 512 + (s0 >> 4)) = pack2(c[res * 132], c[(res + 16) * 132]);
            }
            return;
        }
        const int row = tid >> 2, hsel = (tid >> 1) & 1, half = tid & 1;
        const int head = (tn & 7) * 2 + hsel;
        const int tok = tm * 128 + row, b = tok >> 13, s = tok & 8191;
        float v32[32];
#pragma unroll
        for (int i = 0; i < 8; ++i) { const float4 c = *(const float4*)(sC + row * 132 + hsel * 64 + half * 32 + i * 4); v32[4 * i] = c.x; v32[4 * i + 1] = c.y; v32[4 * i + 2] = c.z; v32[4 * i + 3] = c.w; }
        bf16_t* dst = q + (size_t)which * ((size_t)NTOK * 1024) + ((size_t)(b * NH + head) * SEQ + s) * 64 + half * 32;
        if (which < 2) {
            float ss = 0.f;
#pragma unroll
            for (int i = 0; i < 32; ++i) ss += v32[i] * v32[i];
            const int ht = tn & 7; const bool diff = ht < 2;
            if (!diff) ss += __shfl_xor(ss, 1);
            const float rstd = rsqrtf(ss * (diff ? (1.0f / 32.0f) : (1.0f / 64.0f)) + EPS);
            const float* g = gt + (which * 3 + (ht < 2 ? 0 : ht < 5 ? 1 : 2)) * 64;
            const int goff = diff ? 0 : half * 32;
#pragma unroll
            for (int i = 0; i < 32; ++i) v32[i] = v32[i] * rstd * g[goff + i];
            const float p = (float)pos[tok];
            if (diff) {
#pragma unroll
                for (int i = 0; i < 4; ++i) {
                    const float invf = (i == 0) ? 1.0f : (i == 1) ? 0.037606030930863934f : (i == 2) ? 0.0014142135623730951f : 5.318295896944989e-05f;
                    const float ang = p * invf; const float cs = cosf(ang), sn = sinf(ang);
                    const float x1 = v32[i], x2 = v32[i + 4]; v32[i] = x1 * cs - x2 * sn; v32[i + 4] = x2 * cs + x1 * sn;
                }
            } else if (half == 0) {
#pragma unroll
                for (int i = 0; i < 8; ++i) {
                    const float invf = (i == 0) ? 1.0f : (i == 1) ? 0.19392547244381735f : (i == 2) ? 0.037606030930863934f : (i == 3) ? 0.007292767314834156f :
                                       (i == 4) ? 0.0014142135623730951f : (i == 5) ? 0.0002742520333386866f : (i == 6) ? 5.318295896944989e-05f : 1.0313530666425395e-05f;
                    const float ang = p * invf; const float cs = cosf(ang), sn = sinf(ang);
                    const float x1 = v32[i], x2 = v32[i + 8]; v32[i] = x1 * cs - x2 * sn; v32[i + 8] = x2 * cs + x1 * sn;
                }
            }
        }
#pragma unroll
        for (int i = 0; i < 4; ++i) {
            uint4 w; w.x = pack2(v32[8 * i], v32[8 * i + 1]); w.y = pack2(v32[8 * i + 2], v32[8 * i + 3]); w.z = pack2(v32[8 * i + 4], v32[8 * i + 5]); w.w = pack2(v32[8 * i + 6], v32[8 * i + 7]);
            *(uint4*)(dst + i * 8) = w;
        }
    }
};
struct EpiHeadNorm {
    const float* gain; bf16_t* out; int ldo; int norm_tiles; bf16_t* out2;
    __device__ __forceinline__ void operator()(int tm, int tn, const float* sC, int tid) const {
        const int row = tid >> 2, hsel = (tid >> 1) & 1, half = tid & 1;
        float v32[32];
#pragma unroll
        for (int i = 0; i < 8; ++i) { const float4 c = *(const float4*)(sC + row * 132 + hsel * 64 + half * 32 + i * 4); v32[4 * i] = c.x; v32[4 * i + 1] = c.y; v32[4 * i + 2] = c.z; v32[4 * i + 3] = c.w; }
        bf16_t* dst;
        if (tn < norm_tiles) {
            float ss = 0.f;
#pragma unroll
            for (int i = 0; i < 32; ++i) ss += v32[i] * v32[i];
            ss += __shfl_xor(ss, 1);
            const float rstd = rsqrtf(ss * (1.0f / 64.0f) + EPS);
#pragma unroll
            for (int i = 0; i < 32; ++i) v32[i] = v32[i] * rstd * gain[half * 32 + i];
            dst = out + (size_t)(tm * 128 + row) * ldo + tn * 128 + hsel * 64 + half * 32;
        } else {
            const int hd = (tn - norm_tiles) * 2 + hsel, mr = tm * 128 + row, bb = mr >> 8, mi = mr & 255;
#pragma unroll
            for (int i = 0; i < 32; ++i) out2[((size_t)(bb * 4 + hd) * 64 + half * 32 + i) * 256 + mi] = f2bf(v32[i]);
            return;
        }
#pragma unroll
        for (int i = 0; i < 4; ++i) {
            uint4 w; w.x = pack2(v32[8 * i], v32[8 * i + 1]); w.y = pack2(v32[8 * i + 2], v32[8 * i + 3]); w.z = pack2(v32[8 * i + 4], v32[8 * i + 5]); w.w = pack2(v32[8 * i + 6], v32[8 * i + 7]);
            *(uint4*)(dst + i * 8) = w;
        }
    }
};
struct EpiSwiglu {
    bf16_t* h;
    __device__ __forceinline__ void operator()(int tm, int tn, const float* sC, int tid) const {
        const int row = tid >> 2, c0 = (tid & 3) * 16;
        float o[16];
#pragma unroll
        for (int i = 0; i < 16; ++i) { const float g = sC[row * 132 + c0 + i], u = sC[row * 132 + 64 + c0 + i]; o[i] = g / (1.0f + __expf(-g)) * u; }
        bf16_t* dst = h + (size_t)(tm * 128 + row) * D_FF + tn * 64 + c0;
#pragma unroll
        for (int i = 0; i < 2; ++i) {
            uint4 w; w.x = pack2(o[8 * i], o[8 * i + 1]); w.y = pack2(o[8 * i + 2], o[8 * i + 3]); w.z = pack2(o[8 * i + 4], o[8 * i + 5]); w.w = pack2(o[8 * i + 6], o[8 * i + 7]);
            *(uint4*)(dst + i * 8) = w;
        }
    }
};

namespace pg8 {
#define PG8_LAS __attribute__((address_space(3)))
typedef unsigned short bf16_t;
typedef short bf16x8 __attribute__((ext_vector_type(8)));
typedef float f32x4 __attribute__((ext_vector_type(4)));
typedef unsigned u32x4 __attribute__((ext_vector_type(4)));
constexpr int BM = 256, BK = 64, HALF = 128, HTB = HALF * BK * 2  , STAGE_BYTES = 8 * HTB, NXCD = 8, WGM = 8;

__host__ __device__ __forceinline__ int lds_byte(int r, int c) { const int st = (r >> 4) * 2 + (c >> 5), rr = r & 15, cc = c & 31, ob = rr * 64 + cc * 2; return st * 1024 + (ob ^ (((ob >> 9) & 1) << 5)); }
__host__ __device__ __forceinline__ void stage_rc(int b, int& R, int& C) { const int st = b / 1024, sb = b % 1024, swz = sb ^ (((sb >> 9) & 1) << 5); R = (st >> 1) * 16 + swz / 64; C = (st & 1) * 32 + (swz % 64) / 2; }
__host__ __device__ __forceinline__ int perm32(int rho) { const int n = rho >> 4, i = rho & 15; return 8 * (i >> 2) + 4 * n + (i & 3); }

struct Unit { int pm, pn; };
struct Gemm { const bf16_t* A; const bf16_t* Bt; int M, N, K; };

struct StaticOrder {
    int nM, nN, nwg, G, c;
    __host__ __device__ void init(int M, int N, int G_, int c_) { nM = M / BM; nN = N / BM; nwg = nM * nN; G = G_; c = c_; }
    __host__ __device__ bool next(int i, Unit& u) const {
        const long L = (long)i * G + c; if (L >= nwg) return false;
        int wgid = (int)L; { const int q = nwg / NXCD, r = nwg % NXCD, xcd = wgid % NXCD, off = wgid / NXCD; wgid = (xcd < r ? xcd * (q + 1) : r * (q + 1) + (xcd - r) * q) + off; }
        const int nig = WGM * nN, gid = wgid / nig, fm = gid * WGM, gsz = (nM - fm) < WGM ? (nM - fm) : WGM;
        u.pm = fm + ((wgid % nig) % gsz); u.pn = (wgid % nig) / gsz; return true;
    }
    __device__ __forceinline__ void a_ready(const Unit&) const {}
    __device__ __forceinline__ void done(const Unit&) const {}
};

__device__ __forceinline__ unsigned cvt_pk_bf16(float lo, float hi) { const ::f32x2c v = {lo, hi}; return __builtin_bit_cast(unsigned, __builtin_convertvector(v, ::bf16x2c)); }
typedef unsigned u32x4 __attribute__((ext_vector_type(4)));
struct EpiResid2 {
    static constexpr bool PERM = false, AFTER_DRAIN = false;
    const float* src; float* out; bf16_t* xb; float* part;
    __device__ __forceinline__ void operator()(const f32x4 (&acc)[2][2][4][2], const Unit& u, int wr, int wc, int fr, int fq) const {
#pragma unroll
        for (int ai = 0; ai < 2; ++ai)
#pragma unroll
            for (int m = 0; m < 4; ++m) {
                const int row = u.pm * BM + ai * HALF + wr * 64 + m * 16 + fr;
                const size_t off = (size_t)row * 1024 + u.pn * BM + wc * 32 + 4 * fq;
                float ss = 0.f;
#pragma unroll
                for (int bj = 0; bj < 2; ++bj)
#pragma unroll
                    for (int n = 0; n < 2; ++n) {
                        const size_t o = off + bj * HALF + n * 16; const f32x4 sv = *(const f32x4*)(src + o); const f32x4 r = sv + acc[ai][bj][m][n];
                        *(f32x4*)(out + o) = r;
                        if (xb) { ss += r[0] * r[0] + r[1] * r[1] + r[2] * r[2] + r[3] * r[3]; uint2 w; w.x = cvt_pk_bf16(r[0], r[1]); w.y = cvt_pk_bf16(r[2], r[3]); *(uint2*)(xb + o) = w; }
                    }
                if (xb) {
                    ss += __shfl_xor(ss, 16); ss += __shfl_xor(ss, 32);
                    if (fq == 0) part[(size_t)row * 16 + u.pn * 4 + wc] = ss;
                }
            }
    }
};
__device__ __forceinline__ float row_rstd(const float* part, int row) {
    const f32x4* p = (const f32x4*)(part + (size_t)row * 16);
    const f32x4 a = p[0], b = p[1], c = p[2], d = p[3];
    const float ss = ((a[0] + a[1]) + (a[2] + a[3])) + ((b[0] + b[1]) + (b[2] + b[3])) + ((c[0] + c[1]) + (c[2] + c[3])) + ((d[0] + d[1]) + (d[2] + d[3]));
    float r = rsqrtf(ss * (1.0f / 1024.0f) + 1e-6f);
    asm volatile("" : "+v"(r) : : "memory");
    return r;
}
struct EpiQK {
    static constexpr bool PERM = true, AFTER_DRAIN = false;
    const float* gt; const float* cs; bf16_t* qk; const float* part;
    __device__ __forceinline__ void operator()(const f32x4 (&acc)[2][2][4][2], const Unit& u, int wr, int wc, int fr, int fq) const {
        const int which = u.pn >> 2, head = (u.pn & 3) * 4 + wc, type = head < 4 ? 0 : (head < 10 ? 1 : 2);
        const bool diff = type == 0;
        const float* g = gt + (which * 3 + type) * 64;
        f32x4 gv[2][2];
#pragma unroll
        for (int bj = 0; bj < 2; ++bj)
#pragma unroll
            for (int n = 0; n < 2; ++n) gv[bj][n] = *(const f32x4*)(g + (diff ? 0 : 32 * bj) + 8 * fq + 4 * n);
        bf16_t* base = qk + (size_t)which * ((size_t)16384 * 1024);
#pragma unroll
        for (int ai = 0; ai < 2; ++ai)
#pragma unroll
            for (int m = 0; m < 4; ++m) {
                const int tok = u.pm * BM + ai * HALF + wr * 64 + m * 16 + fr, b = tok >> 13, sp = tok & 8191;
                f32x4 v[2][2];
                const float rs0 = row_rstd(part, tok);
#pragma unroll
                for (int bj = 0; bj < 2; ++bj)
#pragma unroll
                    for (int n = 0; n < 2; ++n) v[bj][n] = acc[ai][bj][m][n] * rs0;
                const f32x4* cp = (const f32x4*)(cs + (size_t)tok * 16);
                const f32x4 c0 = cp[0], c1 = cp[1], c2 = cp[2], c3 = cp[3];
                if (diff) {
#pragma unroll
                    for (int bj = 0; bj < 2; ++bj) {
                        float ss = 0.f;
#pragma unroll
                        for (int n = 0; n < 2; ++n) ss += v[bj][n][0] * v[bj][n][0] + v[bj][n][1] * v[bj][n][1] + v[bj][n][2] * v[bj][n][2] + v[bj][n][3] * v[bj][n][3];
                        ss += __shfl_xor(ss, 16); ss += __shfl_xor(ss, 32);
                        const float rstd = rsqrtf(ss * (1.0f / 32.0f) + 1e-6f);
#pragma unroll
                        for (int n = 0; n < 2; ++n) v[bj][n] = v[bj][n] * rstd * gv[bj][n];
                        if (fq == 0) {
                            const float cc[4] = {c0[0], c1[0], c2[0], c3[0]}, sn[4] = {c0[1], c1[1], c2[1], c3[1]};
#pragma unroll
                            for (int e = 0; e < 4; ++e) { const float x1 = v[bj][0][e], x2 = v[bj][1][e]; v[bj][0][e] = x1 * cc[e] - x2 * sn[e]; v[bj][1][e] = x2 * cc[e] + x1 * sn[e]; }
                        }
                    }
                } else {
                    float ss = 0.f;
#pragma unroll
                    for (int bj = 0; bj < 2; ++bj)
#pragma unroll
                        for (int n = 0; n < 2; ++n) ss += v[bj][n][0] * v[bj][n][0] + v[bj][n][1] * v[bj][n][1] + v[bj][n][2] * v[bj][n][2] + v[bj][n][3] * v[bj][n][3];
                    ss += __shfl_xor(ss, 16); ss += __shfl_xor(ss, 32);
                    const float rstd = rsqrtf(ss * (1.0f / 64.0f) + 1e-6f);
#pragma unroll
                    for (int bj = 0; bj < 2; ++bj)
#pragma unroll
                        for (int n = 0; n < 2; ++n) v[bj][n] = v[bj][n] * rstd * gv[bj][n];
                    const float cc[8] = {c0[0], c0[2], c1[0], c1[2], c2[0], c2[2], c3[0], c3[2]}, sn[8] = {c0[1], c0[3], c1[1], c1[3], c2[1], c2[3], c3[1], c3[3]};
#pragma unroll
                    for (int n = 0; n < 2; ++n)
#pragma unroll
                        for (int e = 0; e < 4; ++e) {
                            const float mine = v[0][n][e], other = __shfl_xor(mine, 16);
                            const float sgn = fq == 0 ? -1.0f : 1.0f;
                            const float rot = mine * cc[4 * n + e] + sgn * other * sn[4 * n + e];
                            v[0][n][e] = fq < 2 ? rot : mine;
                        }
                }
                bf16_t* dst = base + ((size_t)(b * 16 + head) * 8192 + sp) * 64 + 8 * fq;
#pragma unroll
                for (int bj = 0; bj < 2; ++bj) {
                    u32x4 w; w.x = cvt_pk_bf16(v[bj][0][0], v[bj][0][1]); w.y = cvt_pk_bf16(v[bj][0][2], v[bj][0][3]); w.z = cvt_pk_bf16(v[bj][1][0], v[bj][1][1]); w.w = cvt_pk_bf16(v[bj][1][2], v[bj][1][3]);
                    *(u32x4*)(dst + 32 * bj) = w;
                }
            }
    }
};
struct EpiVT {
    static constexpr bool PERM = true, AFTER_DRAIN = false;
    bf16_t* vt; const float* part;
    __device__ __forceinline__ void operator()(const f32x4 (&acc)[2][2][4][2], const Unit& u, int wr, int wc, int fr, int fq) const {
        f32x4 rsa[2], rsc[2];
#pragma unroll
        for (int bj = 0; bj < 2; ++bj) {
            const int tok0 = u.pn * BM + bj * HALF + wc * 32 + 8 * fq;
#pragma unroll
            for (int e = 0; e < 4; ++e) { rsa[bj][e] = row_rstd(part, tok0 + e); rsc[bj][e] = row_rstd(part, tok0 + 4 + e); }
        }
#pragma unroll
        for (int ai = 0; ai < 2; ++ai) {
            const int head = u.pm * 4 + ai * 2 + wr;
            const bool dil = head >= 4 && head < 10;
            const int slot = head < 4 ? head : (head >= 10 ? head - 6 : 10 + (head - 4) * 3);
#pragma unroll
            for (int m = 0; m < 4; ++m) {
                const int d = m * 16 + fr;
#pragma unroll
                for (int bj = 0; bj < 2; ++bj) {
                    const int tok0 = u.pn * BM + bj * HALF + wc * 32 + 8 * fq, b = tok0 >> 13, sp = tok0 & 8191;
                    const f32x4 a = acc[ai][bj][m][0] * rsa[bj], c = acc[ai][bj][m][1] * rsc[bj];
                    bf16_t* dst = vt + ((size_t)(b * 28 + slot) * 64 + d) * 8192;
                    u32x4 w; w.x = cvt_pk_bf16(a[0], a[1]); w.y = cvt_pk_bf16(a[2], a[3]); w.z = cvt_pk_bf16(c[0], c[1]); w.w = cvt_pk_bf16(c[2], c[3]);
                    *(u32x4*)(dst + sp) = w;
                    if (dil) {
                        bf16_t* d4 = dst + (size_t)64 * 8192; bf16_t* d16 = dst + (size_t)128 * 8192;
#pragma unroll
                        for (int e = 0; e < 4; ++e) *(unsigned*)(d4 + e * 2048 + (sp >> 2)) = cvt_pk_bf16(a[e], c[e]);
#pragma unroll
                        for (int e = 0; e < 4; ++e) {
                            const unsigned pa = cvt_pk_bf16(a[e], c[e]);
                            d16[((sp & 15) + e) * 512 + (sp >> 4)] = (bf16_t)(pa & 0xffffu);
                            d16[((sp & 15) + e + 4) * 512 + (sp >> 4)] = (bf16_t)(pa >> 16);
                        }
                    }
                }
            }
        }
    }
};
struct EpiHead2 {
    static constexpr bool PERM = true, AFTER_DRAIN = false;
    const float* gain; bf16_t* out; bf16_t* vmt; const float* part;
    __device__ __forceinline__ void operator()(const f32x4 (&acc)[2][2][4][2], const Unit& u, int wr, int wc, int fr, int fq) const {
        f32x4 gv[2][2];
#pragma unroll
        for (int bj = 0; bj < 2; ++bj)
#pragma unroll
            for (int n = 0; n < 2; ++n) gv[bj][n] = *(const f32x4*)(gain + 32 * bj + 8 * fq + 4 * n);
#pragma unroll
        for (int ai = 0; ai < 2; ++ai)
#pragma unroll
            for (int m = 0; m < 4; ++m) {
                const int row = u.pm * BM + ai * HALF + wr * 64 + m * 16 + fr;
                if (u.pn == 0) {
                    const float rs0 = part ? row_rstd(part, row) : 1.0f;
                    float ss = 0.f;
#pragma unroll
                    for (int bj = 0; bj < 2; ++bj)
#pragma unroll
                        for (int n = 0; n < 2; ++n) { const f32x4 x = acc[ai][bj][m][n] * rs0; ss += x[0] * x[0] + x[1] * x[1] + x[2] * x[2] + x[3] * x[3]; }
                    ss += __shfl_xor(ss, 16); ss += __shfl_xor(ss, 32);
                    const float rstd = rsqrtf(ss * (1.0f / 64.0f) + 1e-6f) * rs0;
                    bf16_t* dst = out + (size_t)row * 256 + 64 * wc + 8 * fq;
#pragma unroll
                    for (int bj = 0; bj < 2; ++bj) {
                        const f32x4 x0 = acc[ai][bj][m][0] * rstd * gv[bj][0], x1 = acc[ai][bj][m][1] * rstd * gv[bj][1];
                        u32x4 w; w.x = cvt_pk_bf16(x0[0], x0[1]); w.y = cvt_pk_bf16(x0[2], x0[3]); w.z = cvt_pk_bf16(x1[0], x1[1]); w.w = cvt_pk_bf16(x1[2], x1[3]);
                        *(u32x4*)(dst + 32 * bj) = w;
                    }
                } else {
                    const int b = row >> 8, mi = row & 255;
#pragma unroll
                    for (int bj = 0; bj < 2; ++bj)
#pragma unroll
                        for (int n = 0; n < 2; ++n)
#pragma unroll
                            for (int e = 0; e < 4; ++e) {
                                const unsigned pk = cvt_pk_bf16(acc[ai][bj][m][n][e], 0.f);
                                vmt[((size_t)(b * 4 + wc) * 64 + 32 * bj + 8 * fq + 4 * n + e) * 256 + mi] = (bf16_t)(pk & 0xffffu);
                            }
                }
            }
    }
};
struct EpiSwiglu2 {
    static constexpr bool PERM = true, AFTER_DRAIN = false;
    bf16_t* h; const float* part;
    __device__ __forceinline__ void operator()(const f32x4 (&acc)[2][2][4][2], const Unit& u, int wr, int wc, int fr, int fq) const {
#pragma unroll
        for (int ai = 0; ai < 2; ++ai)
#pragma unroll
            for (int m = 0; m < 4; ++m) {
                const int row = u.pm * BM + ai * HALF + wr * 64 + m * 16 + fr;
                const float rs0 = row_rstd(part, row);
                float o[8];
#pragma unroll
                for (int n = 0; n < 2; ++n)
#pragma unroll
                    for (int e = 0; e < 4; ++e) { const float g = acc[ai][0][m][n][e] * rs0, up = acc[ai][1][m][n][e] * rs0; o[4 * n + e] = g * __builtin_amdgcn_rcpf(1.0f + __expf(-g)) * up; }
                u32x4 w; w.x = cvt_pk_bf16(o[0], o[1]); w.y = cvt_pk_bf16(o[2], o[3]); w.z = cvt_pk_bf16(o[4], o[5]); w.w = cvt_pk_bf16(o[6], o[7]);
                *(u32x4*)(h + (size_t)row * 2816 + u.pn * 128 + wc * 32 + 8 * fq) = w;
            }
    }
};
template <class Epi, class Sched, bool ALIGN_EPI = false, bool SP2 = false>
__device__ __forceinline__ void gemm_phase(PG8_LAS unsigned char* lds, const Gemm g, const Sched& S, const Epi& E) {
    const int tid = opaque_tid(), wid = __builtin_amdgcn_readfirstlane(tid >> 6), lane = tid & 63, wr = wid >> 2, wc = wid & 3, fr = lane & 15, fq = lane >> 4;
    const int K = g.K, nt = K / BK;
    unsigned voffA[2], voffB[2];
#pragma unroll
    for (int i = 0; i < 2; ++i) { int R, C; stage_rc(tid * 16 + i * 8192, R, C); const int Rb = Epi::PERM ? ((R & ~31) + perm32(R & 31)) : R;
        voffA[i] = (unsigned)(R * K + C) * 2u; voffB[i] = (unsigned)(Rb * K + C) * 2u; }
    const size_t kstep = (size_t)(BK * 2);
    const size_t hstep = (size_t)HALF * K * 2;
    const size_t tstep = 2 * hstep;
    const unsigned ldsw = (unsigned)wid * 1024u;
    const int aoff = lds_byte(wr * 64 + fr, fq * 8), boff = lds_byte(wc * 32 + fr, fq * 8);
#define PG8_SA(b, h) (((b) * 2 + (h)) * HTB)
#define PG8_SB(b, h) ((4 + (b) * 2 + (h)) * HTB)
#define PG8_STAGE(bufoff, gbase, voff) do { _Pragma("unroll") for (int _i = 0; _i < 2; ++_i) \
        __builtin_amdgcn_global_load_lds((const unsigned*)((const char*)(gbase) + (voff)[_i]), (PG8_LAS unsigned*)(lds + (bufoff) + ldsw + _i * 8192), 16, 0, 0); } while (0)
#define PG8_LDA(dst, b, h) do { _Pragma("unroll") for (int m = 0; m < 4; ++m) _Pragma("unroll") for (int k = 0; k < 2; ++k) dst[m][k] = *(const PG8_LAS bf16x8*)(lds + PG8_SA(b, h) + aoff + m * 2048 + k * 1024); } while (0)
#define PG8_LDB(dst, b, h) do { _Pragma("unroll") for (int n = 0; n < 2; ++n) _Pragma("unroll") for (int k = 0; k < 2; ++k) dst[n][k] = *(const PG8_LAS bf16x8*)(lds + PG8_SB(b, h) + boff + n * 2048 + k * 1024); } while (0)
#define PG8_MMA(ai, bj, At, Bt) do { __builtin_amdgcn_s_setprio(1); _Pragma("unroll") for (int m = 0; m < 4; ++m) _Pragma("unroll") for (int n = 0; n < 2; ++n) _Pragma("unroll") for (int k = 0; k < 2; ++k) \
        acc[ai][bj][m][n] = __builtin_amdgcn_mfma_f32_16x16x32_bf16(Bt[n][k], At[m][k], acc[ai][bj][m][n], 0, 0, 0); __builtin_amdgcn_s_setprio(0); } while (0)
#define PG8_WAIT_V(n) asm volatile("s_waitcnt vmcnt(" #n ")" ::: "memory")
#define PG8_WAIT_L(n) asm volatile("s_waitcnt lgkmcnt(" #n ")" ::: "memory")
#define PG8_BAR __builtin_amdgcn_s_barrier()
#define PG8_SCHED __builtin_amdgcn_sched_barrier(0)
    Unit cur, nxt; int ui = 0;
    if (!S.next(0, cur)) return;
    f32x4 acc[2][2][4][2];
#pragma unroll
    for (int a = 0; a < 2; ++a)
#pragma unroll
        for (int b = 0; b < 2; ++b)
#pragma unroll
            for (int m = 0; m < 4; ++m)
#pragma unroll
                for (int n = 0; n < 2; ++n) acc[a][b][m][n] = (f32x4){0.f, 0.f, 0.f, 0.f};
    bf16x8 At[4][2], B0[2][2], B1[2][2];
    const char* cA = (const char*)g.A + (size_t)cur.pm * tstep; const char* cB = (const char*)g.Bt + (size_t)cur.pn * tstep;
    S.a_ready(cur);
    if constexpr (SP2) {
        PG8_STAGE(PG8_SB(0, 0), cB, voffB); PG8_STAGE(PG8_SB(0, 1), cB + hstep, voffB); PG8_STAGE(PG8_SA(0, 0), cA, voffA); PG8_STAGE(PG8_SA(0, 1), cA + hstep, voffA);
        if (wr == 1) PG8_BAR;
        PG8_WAIT_V(2); PG8_BAR;
        PG8_STAGE(PG8_SB(1, 0), cB + kstep, voffB); PG8_STAGE(PG8_SA(1, 0), cA + kstep, voffA); PG8_STAGE(PG8_SB(1, 1), cB + hstep + kstep, voffB);
        PG8_WAIT_V(6); PG8_BAR;
    } else {
        PG8_STAGE(PG8_SB(0, 0), cB, voffB); PG8_STAGE(PG8_SA(0, 0), cA, voffA); PG8_STAGE(PG8_SB(0, 1), cB + hstep, voffB); PG8_STAGE(PG8_SA(0, 1), cA + hstep, voffA);
        if (wr == 1) PG8_BAR;
        PG8_WAIT_V(4); PG8_BAR;
        PG8_STAGE(PG8_SB(1, 0), cB + kstep, voffB); PG8_STAGE(PG8_SA(1, 0), cA + kstep, voffA); PG8_STAGE(PG8_SB(1, 1), cB + hstep + kstep, voffB);
        PG8_WAIT_V(6); PG8_BAR;
    }
    for (;;) {
        const bool has_next = S.next(ui + 1, nxt);
        const char* nA = has_next ? (const char*)g.A + (size_t)nxt.pm * tstep : cA; const char* nB = has_next ? (const char*)g.Bt + (size_t)nxt.pn * tstep : cB;
        for (int t = 0; t < nt; t += 2) {
            const bool last = (t == nt - 2);
            const char* a1 = cA + (size_t)(t + 1) * kstep;
            const char* a2 = last ? nA : cA + (size_t)(t + 2) * kstep; const char* b2 = last ? nB : cB + (size_t)(t + 2) * kstep;
            const char* a3 = a2 + kstep; const char* b3 = b2 + kstep;
            if (last && has_next) S.a_ready(nxt);
            if constexpr (SP2) {
            PG8_LDB(B0, 0, 0); PG8_LDB(B1, 0, 1); PG8_SCHED; PG8_LDA(At, 0, 0); PG8_STAGE(PG8_SA(1, 1), a1 + hstep, voffA);
            PG8_WAIT_V(8); PG8_WAIT_L(0); PG8_BAR; PG8_MMA(0, 0, At, B0); PG8_MMA(0, 1, At, B1); PG8_BAR; PG8_SCHED;
            PG8_LDA(At, 0, 1); PG8_STAGE(PG8_SB(0, 0), b2, voffB); PG8_STAGE(PG8_SB(0, 1), b2 + hstep, voffB); PG8_STAGE(PG8_SA(0, 0), a2, voffA);
            PG8_WAIT_V(8); PG8_WAIT_L(0); PG8_BAR; PG8_MMA(1, 0, At, B0); PG8_MMA(1, 1, At, B1); PG8_BAR; PG8_SCHED;
            PG8_LDB(B0, 1, 0); PG8_LDB(B1, 1, 1); PG8_SCHED; PG8_LDA(At, 1, 0); PG8_STAGE(PG8_SA(0, 1), a2 + hstep, voffA);
            PG8_WAIT_V(8); PG8_WAIT_L(0); PG8_BAR; PG8_MMA(0, 0, At, B0); PG8_MMA(0, 1, At, B1); PG8_BAR; PG8_SCHED;
            PG8_LDA(At, 1, 1); PG8_STAGE(PG8_SB(1, 0), b3, voffB); PG8_STAGE(PG8_SB(1, 1), b3 + hstep, voffB); PG8_STAGE(PG8_SA(1, 0), a3, voffA);
            PG8_WAIT_V(8); PG8_WAIT_L(0); PG8_BAR; PG8_MMA(1, 0, At, B0); PG8_MMA(1, 1, At, B1); PG8_BAR; PG8_SCHED;
            } else {
            PG8_LDB(B0, 0, 0); PG8_SCHED; PG8_LDA(At, 0, 0); PG8_STAGE(PG8_SA(1, 1), a1 + hstep, voffA);
            PG8_WAIT_L(8); PG8_BAR; PG8_WAIT_L(0); PG8_MMA(0, 0, At, B0); PG8_BAR; PG8_SCHED;
            PG8_LDB(B1, 0, 1); PG8_STAGE(PG8_SB(0, 0), b2, voffB);
            PG8_BAR; PG8_WAIT_L(0); PG8_MMA(0, 1, At, B1); PG8_BAR;
            PG8_LDA(At, 0, 1); PG8_STAGE(PG8_SA(0, 0), a2, voffA);
            PG8_BAR; PG8_WAIT_L(0); PG8_MMA(1, 0, At, B0); PG8_BAR; PG8_SCHED;
            PG8_STAGE(PG8_SB(0, 1), b2 + hstep, voffB);
            PG8_WAIT_V(6); PG8_BAR; PG8_MMA(1, 1, At, B1); PG8_BAR;
            PG8_LDB(B0, 1, 0); PG8_SCHED; PG8_LDA(At, 1, 0); PG8_STAGE(PG8_SA(0, 1), a2 + hstep, voffA);
            PG8_WAIT_L(8); PG8_BAR; PG8_WAIT_L(0); PG8_MMA(0, 0, At, B0); PG8_BAR; PG8_SCHED;
            PG8_LDB(B1, 1, 1); PG8_STAGE(PG8_SB(1, 0), b3, voffB);
            PG8_BAR; PG8_WAIT_L(0); PG8_MMA(0, 1, At, B1); PG8_BAR;
            PG8_LDA(At, 1, 1); PG8_STAGE(PG8_SA(1, 0), a3, voffA);
            PG8_BAR; PG8_WAIT_L(0); PG8_MMA(1, 0, At, B0); PG8_BAR; PG8_SCHED;
            PG8_STAGE(PG8_SB(1, 1), b3 + hstep, voffB);
            PG8_WAIT_V(6); PG8_BAR; PG8_MMA(1, 1, At, B1); PG8_BAR;
            }
        }
        if constexpr (ALIGN_EPI) { if (wr == 0) PG8_BAR; }
        if constexpr (!Epi::AFTER_DRAIN) { E(acc, cur, wr, wc, fr, fq); S.done(cur); }
        if (!has_next) break;
#pragma unroll
        for (int a = 0; a < 2; ++a)
#pragma unroll
            for (int b = 0; b < 2; ++b)
#pragma unroll
                for (int m = 0; m < 4; ++m)
#pragma unroll
                    for (int n = 0; n < 2; ++n) acc[a][b][m][n] = (f32x4){0.f, 0.f, 0.f, 0.f};
        cur = nxt; cA = nA; cB = nB; ++ui;
        if constexpr (ALIGN_EPI) { if (wr == 1) PG8_BAR; }
    }
    PG8_WAIT_V(0);
    if constexpr (!ALIGN_EPI) { if (wr == 0) PG8_BAR; }
    PG8_BAR;
    if constexpr (Epi::AFTER_DRAIN) { E.fused(acc, cur, wr, wc, fr, fq, lds, wid, lane); S.done(cur); }
#undef PG8_SA
#undef PG8_SB
#undef PG8_STAGE
#undef PG8_LDA
#undef PG8_LDB
#undef PG8_MMA
#undef PG8_WAIT_V
#undef PG8_WAIT_L
#undef PG8_BAR
#undef PG8_SCHED
}
}

__device__ __forceinline__ void load_row64(const bf16_t* p, float* f) {
#pragma unroll
    for (int i = 0; i < 8; ++i) { const uint4 w = ((const uint4*)p)[i]; f[8 * i] = bflo(w.x); f[8 * i + 1] = bfhi(w.x); f[8 * i + 2] = bflo(w.y); f[8 * i + 3] = bfhi(w.y); f[8 * i + 4] = bflo(w.z); f[8 * i + 5] = bfhi(w.z); f[8 * i + 6] = bflo(w.w); f[8 * i + 7] = bfhi(w.w); }
}
__device__ __forceinline__ void store_row64(bf16_t* p, const float* f) {
#pragma unroll
    for (int i = 0; i < 8; ++i) { uint4 w; w.x = pack2(f[8 * i], f[8 * i + 1]); w.y = pack2(f[8 * i + 2], f[8 * i + 3]); w.z = pack2(f[8 * i + 4], f[8 * i + 5]); w.w = pack2(f[8 * i + 6], f[8 * i + 7]); ((uint4*)p)[i] = w; }
}
template <int NCH> __device__ __forceinline__ float dotk(const bf16_t* kp, const float* q) {
    float s = 0.f;
#pragma unroll
    for (int c = 0; c < NCH; ++c) { const uint4 w = ((const uint4*)kp)[c];
        s += q[8 * c] * bflo(w.x) + q[8 * c + 1] * bfhi(w.x) + q[8 * c + 2] * bflo(w.y) + q[8 * c + 3] * bfhi(w.y) + q[8 * c + 4] * bflo(w.z) + q[8 * c + 5] * bfhi(w.z) + q[8 * c + 6] * bflo(w.w) + q[8 * c + 7] * bfhi(w.w); }
    return s;
}
__device__ __forceinline__ void pv_acc(const bf16_t* vp, float a, float p, float* O) {
#pragma unroll
    for (int c = 0; c < 8; ++c) { const uint4 w = ((const uint4*)vp)[c];
        O[8 * c] = O[8 * c] * a + p * bflo(w.x); O[8 * c + 1] = O[8 * c + 1] * a + p * bfhi(w.x); O[8 * c + 2] = O[8 * c + 2] * a + p * bflo(w.y); O[8 * c + 3] = O[8 * c + 3] * a + p * bfhi(w.y);
        O[8 * c + 4] = O[8 * c + 4] * a + p * bflo(w.z); O[8 * c + 5] = O[8 * c + 5] * a + p * bfhi(w.z); O[8 * c + 6] = O[8 * c + 6] * a + p * bflo(w.w); O[8 * c + 7] = O[8 * c + 7] * a + p * bfhi(w.w); }
}
__device__ __forceinline__ void osm_update(float sc, const bf16_t* vp, float& m, float& l, float* O) {
    const float mn = fmaxf(m, sc), a = __expf(m - mn), p = __expf(sc - mn);
    l = l * a + p; m = mn;
    pv_acc(vp, a, p, O);
}

__device__ __forceinline__ void attn_diff_unit(const Params& P, int l, int u, float lam, float lam_init) {
    const int lane = opaque_tid() & 63, st = lane >> 5;
    const int c = 255 - (u >> 3), bh = u & 7, b = bh >> 2, h = bh & 3;
    const int s = c * 32 + (lane & 31);
    const bf16_t* Q = (const bf16_t*)(P.ws + OFF_Q) + ((size_t)(b * NH + h) * SEQ) * 64 + st * 32;
    const bf16_t* K = (const bf16_t*)(P.ws + OFF_K) + ((size_t)(b * NH + h) * SEQ) * 64 + st * 32;
    const bf16_t* V = (const bf16_t*)(P.ws + OFF_V) + ((size_t)(b * NH + h) * SEQ) * 64;
    float q[32];
#pragma unroll
    for (int i = 0; i < 4; ++i) { const uint4 w = ((const uint4*)(Q + (size_t)s * 64))[i]; q[8 * i] = bflo(w.x); q[8 * i + 1] = bfhi(w.x); q[8 * i + 2] = bflo(w.y); q[8 * i + 3] = bfhi(w.y); q[8 * i + 4] = bflo(w.z); q[8 * i + 5] = bfhi(w.z); q[8 * i + 6] = bflo(w.w); q[8 * i + 7] = bfhi(w.w); }
    const float scale = 0.17677669529663687f;
#pragma unroll
    for (int i = 0; i < 32; ++i) q[i] *= scale;
    float O[64];
#pragma unroll
    for (int i = 0; i < 64; ++i) O[i] = 0.f;
    float m = -1e30f, lsum = 0.f;
    const int jmax = c * 32 + 31;
#pragma unroll 1
    for (int j = 0; j <= jmax; ++j) {
        const float sc = dotk<4>(K + (size_t)j * 64, q);
        if (j <= s) osm_update(sc, V + (size_t)j * 64, m, lsum, O);
    }
    const float inv = (st == 0) ? (1.0f / lsum) : (-lam / lsum);
    float ss = 0.f;
#pragma unroll
    for (int i = 0; i < 64; ++i) { float v = O[i] * inv; v += __shfl_xor(v, 32); O[i] = v; ss += v * v; }
    const float rstd = rsqrtf(ss * (1.0f / 64.0f) + EPS) * (1.0f - lam_init);
    const float* g = P.subln + l * 64;
#pragma unroll
    for (int i = 0; i < 64; ++i) O[i] = O[i] * rstd * g[i];
    if (st == 0) store_row64((bf16_t*)(P.ws + OFF_MIX) + (size_t)(b * SEQ + s) * 1024 + h * 64, O);
}

__device__ __forceinline__ void attn_dil_unit(const Params& P, int u) {
    const int lane = opaque_tid() & 63;
    const int c = u / 12, bh = u % 12, b = bh / 6, h = 4 + bh % 6;
    const int s = c * 64 + lane;
    const bf16_t* Q = (const bf16_t*)(P.ws + OFF_Q) + ((size_t)(b * NH + h) * SEQ) * 64;
    const bf16_t* K = (const bf16_t*)(P.ws + OFF_K) + ((size_t)(b * NH + h) * SEQ) * 64;
    const bf16_t* V = (const bf16_t*)(P.ws + OFF_V) + ((size_t)(b * NH + h) * SEQ) * 64;
    float q[64]; load_row64(Q + (size_t)s * 64, q);
#pragma unroll
    for (int i = 0; i < 64; ++i) q[i] *= 0.125f;
    float O[64];
#pragma unroll
    for (int i = 0; i < 64; ++i) O[i] = 0.f;
    float m = -1e30f, lsum = 0.f;
    for (int br = 0; br < 3; ++br) {
        const int d = br == 0 ? 1 : br == 1 ? 4 : 16;
#pragma unroll 1
        for (int t = 0; t <= 128; ++t) {
            const int kp = s - t * d;
            if (kp >= 0) {
                const float sc = dotk<8>(K + (size_t)kp * 64, q);
                osm_update(sc, V + (size_t)kp * 64, m, lsum, O);
            }
        }
    }
    const float inv = 1.0f / lsum;
#pragma unroll
    for (int i = 0; i < 64; ++i) O[i] *= inv;
    store_row64((bf16_t*)(P.ws + OFF_MIX) + (size_t)(b * SEQ + s) * 1024 + h * 64, O);
}

__device__ __forceinline__ void attn_moba_unit(const Params& P, int u) {
    const int lane = opaque_tid() & 63;
    const int c = 127 - u / 12, bh = u % 12, b = bh / 6, hm = bh % 6, h = 10 + hm;
    const int s = c * 64 + lane, own = c >> 2;
    const bf16_t* Q = (const bf16_t*)(P.ws + OFF_Q) + ((size_t)(b * NH + h) * SEQ) * 64;
    const bf16_t* K = (const bf16_t*)(P.ws + OFF_K) + ((size_t)(b * NH + h) * SEQ) * 64;
    const bf16_t* V = (const bf16_t*)(P.ws + OFF_V) + ((size_t)(b * NH + h) * SEQ) * 64;
    const float* KM = (const float*)(P.ws + OFF_KMEAN) + (size_t)((b * 6 + hm) * 32) * 64;
    float q[64]; load_row64(Q + (size_t)s * 64, q);
    float g0 = -INFINITY, g1 = -INFINITY, g2 = -INFINITY; int n0 = -1, n1 = -1, n2 = -1;
#pragma unroll 1
    for (int n = 0; n < own; ++n) {
        float g = 0.f;
#pragma unroll
        for (int i = 0; i < 64; ++i) g += q[i] * KM[n * 64 + i];
        if (g > g0) { g2 = g1; n2 = n1; g1 = g0; n1 = n0; g0 = g; n0 = n; }
        else if (g > g1) { g2 = g1; n2 = n1; g1 = g; n1 = n; }
        else if (g > g2) { g2 = g; n2 = n; }
    }
#pragma unroll
    for (int i = 0; i < 64; ++i) q[i] *= 0.125f;
    float O[64];
#pragma unroll
    for (int i = 0; i < 64; ++i) O[i] = 0.f;
    float m = -1e30f, lsum = 0.f;
    for (int n = 0; n <= own; ++n) {
        const bool selb = (n == own) || (n == n0) || (n == n1) || (n == n2);
        if (__ballot(selb) == 0ull) continue;
        const int jend = (n == own) ? (c * 64 + 63 - n * 256) : 255;
#pragma unroll 1
        for (int jj = 0; jj <= jend; ++jj) {
            const int j = n * 256 + jj;
            const float sc = dotk<8>(K + (size_t)j * 64, q);
            if (selb && j <= s) osm_update(sc, V + (size_t)j * 64, m, lsum, O);
        }
    }
    const float inv = 1.0f / lsum;
#pragma unroll
    for (int i = 0; i < 64; ++i) O[i] *= inv;
    store_row64((bf16_t*)(P.ws + OFF_MIX) + (size_t)(b * SEQ + s) * 1024 + h * 64, O);
}

typedef float f32x16 __attribute__((ext_vector_type(16)));
__device__ __forceinline__ int swap23(int r) { return (r & ~12) | ((r & 4) << 1) | ((r & 8) >> 1); }
constexpr int AT_ROWB = 144, AT_TILEB = 64 * AT_ROWB, AT_BUFB = 2 * AT_TILEB, AT_QWORD = 2 * AT_BUFB;
__device__ __forceinline__ bf16x8 pack8(const f32x16& x, int s) {
    bf16x8 p; unsigned* pu = (unsigned*)&p;
    pu[0] = pack2(x[8 * s], x[8 * s + 1]); pu[1] = pack2(x[8 * s + 2], x[8 * s + 3]); pu[2] = pack2(x[8 * s + 4], x[8 * s + 5]); pu[3] = pack2(x[8 * s + 6], x[8 * s + 7]);
    return p;
}
template <bool FIXED = false>
__device__ __forceinline__ void osm_tile(f32x16 (&x)[2], float sl2, float& m, float& l, f32x16 (&O)[2], bf16x8 (&pf)[2][2], bool en = true) {
    if (FIXED) {
        const float msubf = en ? m : INFINITY;
        float rsf[4] = {0.f, 0.f, 0.f, 0.f};
#pragma unroll
        for (int sub = 0; sub < 2; ++sub)
#pragma unroll
            for (int g = 0; g < 16; ++g) { const float e = fexp2(fmaf(x[sub][g], sl2, -msubf)); x[sub][g] = e; rsf[g & 3] += e; }
        l += (rsf[0] + rsf[1]) + (rsf[2] + rsf[3]);
#pragma unroll
        for (int sub = 0; sub < 2; ++sub) { pf[sub][0] = pack8(x[sub], 0); pf[sub][1] = pack8(x[sub], 1); }
        return;
    }
    float ma = fmaxf(x[0][0], fmaxf(x[0][1], x[0][2])), mb = fmaxf(x[0][8], fmaxf(x[0][9], x[0][10]));
    float mc = fmaxf(x[1][0], fmaxf(x[1][1], x[1][2])), md = fmaxf(x[1][8], fmaxf(x[1][9], x[1][10]));
#pragma unroll
    for (int g = 3; g < 7; g += 2) {
        ma = fmaxf(ma, fmaxf(x[0][g], x[0][g + 1])); mb = fmaxf(mb, fmaxf(x[0][g + 8], x[0][g + 9]));
        mc = fmaxf(mc, fmaxf(x[1][g], x[1][g + 1])); md = fmaxf(md, fmaxf(x[1][g + 8], x[1][g + 9]));
    }
    ma = fmaxf(ma, x[0][7]); mb = fmaxf(mb, x[0][15]); mc = fmaxf(mc, x[1][7]); md = fmaxf(md, x[1][15]);
    float mx = fmaxf(fmaxf(ma, mb), fmaxf(mc, md));
    mx = en ? mx : -INFINITY;
    mx = fmaxf(mx, __shfl_xor(mx, 32));
    const float mxs = mx * sl2;
    if (__ballot(mxs - m > 8.0f) != 0ull) {
        const float mn = fmaxf(m, mxs), alpha = fexp2(m - mn);
        m = mn; l *= alpha;
#pragma unroll
        for (int dt = 0; dt < 2; ++dt)
#pragma unroll
            for (int g = 0; g < 16; ++g) O[dt][g] *= alpha;
    }
    const float msub = en ? m : INFINITY;
    float rs[4] = {0.f, 0.f, 0.f, 0.f};
#pragma unroll
    for (int sub = 0; sub < 2; ++sub)
#pragma unroll
        for (int g = 0; g < 16; ++g) { const float e = fexp2(fmaf(x[sub][g], sl2, -msub)); x[sub][g] = e; rs[g & 3] += e; }
    l += (rs[0] + rs[1]) + (rs[2] + rs[3]);
#pragma unroll
    for (int sub = 0; sub < 2; ++sub) { pf[sub][0] = pack8(x[sub], 0); pf[sub][1] = pack8(x[sub], 1); }
}

__device__ __forceinline__ void osm_fix_sub(f32x16& x, float sl2, float m, float& l, bf16x8 (&pf)[2], bool en = true) {
    const float msub = en ? m : INFINITY;
    float rs[4] = {0.f, 0.f, 0.f, 0.f};
#pragma unroll
    for (int g = 0; g < 16; ++g) { const float e = fexp2(fmaf(x[g], sl2, -msub)); x[g] = e; rs[g & 3] += e; }
    l += (rs[0] + rs[1]) + (rs[2] + rs[3]);
    pf[0] = pack8(x, 0); pf[1] = pack8(x, 1);
}
__device__ __forceinline__ float compute_lam(const Params& P, int l, float lam_init) {
    const int lane = opaque_tid() & 63;
    float a1 = 0.f, a2 = 0.f;
    if (lane < 32) { a1 = P.lq1[l * 32 + lane] * P.lk1[l * 32 + lane]; a2 = P.lq2[l * 32 + lane] * P.lk2[l * 32 + lane]; }
#pragma unroll
    for (int o = 32; o > 0; o >>= 1) { a1 += __shfl_xor(a1, o); a2 += __shfl_xor(a2, o); }
    return expf(a1) - expf(a2) + lam_init;
}
template <int MODE> __device__ __forceinline__ void attn_mfma_unit(const Params& P, unsigned char* lds, int l, int b, int h, int qb) {
    const int tid = opaque_tid(), lane = tid & 63, wid = tid >> 6, r = lane & 31, hh = lane >> 5;
    const size_t bh = (size_t)(b * NH + h);
    const bf16_t* Qg = (const bf16_t*)(P.ws + OFF_Q) + bh * SEQ * 64;
    const bf16_t* Kg = (const bf16_t*)(P.ws + OFF_K) + bh * SEQ * 64;
    const bf16_t* VTg = (const bf16_t*)(P.ws + OFF_V) + (size_t)(b * NVSLOT + (MODE == 0 ? h : h - 6)) * SEQ * 64;
    const int q0 = qb * 256 + wid * 32, sq = q0 + r;
    bf16x8 qf[4];
#pragma unroll
    for (int ks = 0; ks < 4; ++ks) qf[ks] = *(const bf16x8*)(Qg + (size_t)sq * 64 + 16 * ks + 8 * hh);
    int n0 = -1, n1 = -1, n2 = -1;
    if (MODE == 1) {
        const int hm = h - 10, own = qb;
        const float* KM = (const float*)(P.ws + OFF_KMEAN) + (size_t)((b * 6 + hm) * 32) * 64;
        float qv[64]; load_row64(Qg + (size_t)sq * 64, qv);
        float g0 = -INFINITY, g1 = -INFINITY, g2 = -INFINITY;
#pragma unroll 1
        for (int n = 0; n < own; ++n) {
            float g = 0.f;
#pragma unroll
            for (int i = 0; i < 64; ++i) g += qv[i] * KM[n * 64 + i];
            if (g > g0) { g2 = g1; n2 = n1; g1 = g0; n1 = n0; g0 = g; n0 = n; }
            else if (g > g1) { g2 = g1; n2 = n1; g1 = g; n1 = n; }
            else if (g > g2) { g2 = g; n2 = n; }
        }
    }
    const float sl2 = (MODE == 0 ? 0.17677669529663687f : 0.125f) * 1.4426950408889634f;
    f32x16 O1[2], O2[2];
#pragma unroll
    for (int dt = 0; dt < 2; ++dt)
#pragma unroll
        for (int g = 0; g < 16; ++g) { O1[dt][g] = 0.f; O2[dt][g] = 0.f; }
    const float mfix = ((const float*)(P.ws + OFF_SB))[l * 4 + (MODE == 0 ? 0 : 1)];
    float m1 = mfix, l1 = 0.f, l2 = 0.f;
    const int lrow = tid >> 3, lch = tid & 7;
    const bf16_t* kload = Kg + (size_t)lrow * 64 + lch * 8;
    const bf16_t* vload = VTg + (size_t)lrow * SEQ + lch * 8;
    const int lwoff = lrow * AT_ROWB + lch * 16;
    const int ntile = 4 * (qb + 1);
    uint4 kr = *(const uint4*)kload, vr = *(const uint4*)vload;
    __syncthreads();
    *(uint4*)(lds + lwoff) = kr; *(uint4*)(lds + AT_TILEB + lwoff) = vr;
    __syncthreads();
    const int krow_off = swap23(r) * AT_ROWB + hh * 16, vrow_off = r * AT_ROWB + hh * 16;
#pragma unroll 1
    for (int t = 0; t < ntile; ++t) {
        const int k0 = t * 64;
        if (t + 1 < ntile) { kr = *(const uint4*)(kload + (size_t)(k0 + 64) * 64); vr = *(const uint4*)(vload + k0 + 64); }
        bool need = k0 <= q0 + 31;
        bool selb = true;
        if (MODE == 1) { const int n = t >> 2; selb = (n == qb) || (n == n0) || (n == n1) || (n == n2); need = need && (__ballot(selb) != 0ull); }
        if (need) {
            const unsigned char* kb = lds + (t & 1) * AT_BUFB; const unsigned char* vb = kb + AT_TILEB;
            f32x16 xa[2], xb[2];
            bf16x8 kfr[2][4];
#pragma unroll
            for (int sub = 0; sub < 2; ++sub)
#pragma unroll
                for (int ks = 0; ks < 4; ++ks) kfr[sub][ks] = *(const bf16x8*)(kb + sub * 32 * AT_ROWB + krow_off + ks * 32);
            __builtin_amdgcn_sched_barrier(0);
#pragma unroll
            for (int sub = 0; sub < 2; ++sub) {
#pragma unroll
                for (int g = 0; g < 16; ++g) { xa[sub][g] = 0.f; xb[sub][g] = 0.f; }
#pragma unroll
                for (int ks = 0; ks < 4; ++ks) {
                    if (MODE == 0 && ks >= 2) xb[sub] = __builtin_amdgcn_mfma_f32_32x32x16_bf16(kfr[sub][ks], qf[ks], xb[sub], 0, 0, 0);
                    else xa[sub] = __builtin_amdgcn_mfma_f32_32x32x16_bf16(kfr[sub][ks], qf[ks], xa[sub], 0, 0, 0);
                }
            }
            if (k0 + 63 > q0) {
#pragma unroll
                for (int sub = 0; sub < 2; ++sub)
#pragma unroll
                    for (int g = 0; g < 16; ++g) {
                        const int kp = k0 + sub * 32 + (g & 7) + 8 * hh + 16 * (g >> 3);
                        if (kp > sq) { xa[sub][g] = -INFINITY; if (MODE == 0) xb[sub][g] = -INFINITY; }
                    }
            }
            bf16x8 vfr[2][2][2];
#pragma unroll
            for (int dt = 0; dt < 2; ++dt)
#pragma unroll
                for (int sub = 0; sub < 2; ++sub)
#pragma unroll
                    for (int s = 0; s < 2; ++s) vfr[dt][sub][s] = *(const bf16x8*)(vb + dt * 32 * AT_ROWB + vrow_off + (sub * 32 + 16 * s) * 2);
            __builtin_amdgcn_sched_barrier(0);
#pragma unroll
            for (int sub = 0; sub < 2; ++sub) {
                bf16x8 pp[2];
                osm_fix_sub(xa[sub], sl2, m1, l1, pp, selb);
#pragma unroll
                for (int dt = 0; dt < 2; ++dt)
#pragma unroll
                    for (int s = 0; s < 2; ++s) O1[dt] = __builtin_amdgcn_mfma_f32_32x32x16_bf16(vfr[dt][sub][s], pp[s], O1[dt], 0, 0, 0);
                if (MODE == 0) {
                    bf16x8 pq[2];
                    osm_fix_sub(xb[sub], sl2, m1, l2, pq);
#pragma unroll
                    for (int dt = 0; dt < 2; ++dt)
#pragma unroll
                        for (int s = 0; s < 2; ++s) O2[dt] = __builtin_amdgcn_mfma_f32_32x32x16_bf16(vfr[dt][sub][s], pq[s], O2[dt], 0, 0, 0);
                }
            }
        }
        if (t + 1 < ntile) { unsigned char* wb = lds + ((t + 1) & 1) * AT_BUFB; *(uint4*)(wb + lwoff) = kr; *(uint4*)(wb + AT_TILEB + lwoff) = vr; }
        __syncthreads();
    }
    l1 += __shfl_xor(l1, 32);
    bf16_t* dst = (bf16_t*)(P.ws + OFF_MIX) + (size_t)(b * SEQ + sq) * 1024 + h * 64;
    if (MODE == 0) {
        l2 += __shfl_xor(l2, 32);
        int lq = l; asm volatile("" : "+s"(lq));
        const float lam_init = (lq == 0) ? 0.2f : 0.3555090675909693f;
        const float lam = compute_lam(P, l, lam_init);
        const float i1 = 1.0f / l1, i2 = lam / l2;
        float ss = 0.f;
#pragma unroll
        for (int dt = 0; dt < 2; ++dt)
#pragma unroll
            for (int g = 0; g < 16; ++g) { const float v = O1[dt][g] * i1 - O2[dt][g] * i2; O1[dt][g] = v; ss += v * v; }
        ss += __shfl_xor(ss, 32);
        const float rstd = rsqrtf(ss * (1.0f / 64.0f) + EPS) * (1.0f - lam_init);
        const float* gn = P.subln + l * 64;
#pragma unroll
        for (int dt = 0; dt < 2; ++dt)
#pragma unroll
            for (int gq = 0; gq < 4; ++gq) {
                const int d = 32 * dt + 8 * gq + 4 * hh;
                uint2 w; w.x = pack2(O1[dt][4 * gq] * rstd * gn[d], O1[dt][4 * gq + 1] * rstd * gn[d + 1]); w.y = pack2(O1[dt][4 * gq + 2] * rstd * gn[d + 2], O1[dt][4 * gq + 3] * rstd * gn[d + 3]);
                *(uint2*)(dst + d) = w;
            }
    } else {
        const float i1 = 1.0f / l1;
#pragma unroll
        for (int dt = 0; dt < 2; ++dt)
#pragma unroll
            for (int gq = 0; gq < 4; ++gq) {
                const int d = 32 * dt + 8 * gq + 4 * hh;
                uint2 w; w.x = pack2(O1[dt][4 * gq] * i1, O1[dt][4 * gq + 1] * i1); w.y = pack2(O1[dt][4 * gq + 2] * i1, O1[dt][4 * gq + 3] * i1);
                *(uint2*)(dst + d) = w;
            }
    }
}

__device__ __forceinline__ void wave_load(const bf16_t* kp, const bf16_t* vtp, size_t vts32, bf16x8 (&kf)[4], bf16x8 (&vf)[2][2]) {
#pragma unroll
    for (int ks = 0; ks < 4; ++ks) kf[ks] = *(const bf16x8*)(kp + 16 * ks);
#pragma unroll
    for (int dt = 0; dt < 2; ++dt)
#pragma unroll
        for (int s2 = 0; s2 < 2; ++s2) vf[dt][s2] = *(const bf16x8*)(vtp + dt * vts32 + 16 * s2);
}
template <class MaskFn>
__device__ __forceinline__ void wave_compute(const bf16x8 (&kf)[4], const bf16x8 (&vf)[2][2], const bf16x8 (&qf)[4], MaskFn mask, float sl2, float& m, float& l, f32x16 (&O)[2]) {
    f32x16 x;
#pragma unroll
    for (int g = 0; g < 16; ++g) x[g] = 0.f;
#pragma unroll
    for (int ks = 0; ks < 4; ++ks) x = __builtin_amdgcn_mfma_f32_32x32x16_bf16(kf[ks], qf[ks], x, 0, 0, 0);
#pragma unroll
    for (int g = 0; g < 16; ++g) if (!mask(g)) x[g] = -INFINITY;
    float mx = x[0];
#pragma unroll
    for (int g = 1; g < 16; ++g) mx = fmaxf(mx, x[g]);
    mx = fmaxf(mx, __shfl_xor(mx, 32));
    const float mn = fmaxf(m, mx * sl2), alpha = fexp2(m - mn);
    m = mn;
    float rs = 0.f;
#pragma unroll
    for (int g = 0; g < 16; ++g) { const float e = fexp2(fmaf(x[g], sl2, -mn)); x[g] = e; rs += e; }
    l = l * alpha + rs;
    if (__ballot(alpha != 1.0f) != 0ull) {
#pragma unroll
        for (int dt = 0; dt < 2; ++dt)
#pragma unroll
            for (int g = 0; g < 16; ++g) O[dt][g] *= alpha;
    }
    const bf16x8 p0 = pack8(x, 0), p1 = pack8(x, 1);
#pragma unroll
    for (int dt = 0; dt < 2; ++dt) {
        O[dt] = __builtin_amdgcn_mfma_f32_32x32x16_bf16(vf[dt][0], p0, O[dt], 0, 0, 0);
        O[dt] = __builtin_amdgcn_mfma_f32_32x32x16_bf16(vf[dt][1], p1, O[dt], 0, 0, 0);
    }
}
__device__ __forceinline__ void wave_store(bf16_t* dst, const f32x16 (&O)[2], float l, int hh) {
    l += __shfl_xor(l, 32);
    const float inv = 1.0f / l;
#pragma unroll
    for (int dt = 0; dt < 2; ++dt)
#pragma unroll
        for (int gq = 0; gq < 4; ++gq) {
            const int d = 32 * dt + 8 * gq + 4 * hh;
            uint2 w; w.x = pack2(O[dt][4 * gq] * inv, O[dt][4 * gq + 1] * inv); w.y = pack2(O[dt][4 * gq + 2] * inv, O[dt][4 * gq + 3] * inv);
            *(uint2*)(dst + d) = w;
        }
}
__device__ __forceinline__ void attn_dil_mfma(const Params& P, int u) {
    const int lane = opaque_tid() & 63, r = lane & 31, hh = lane >> 5;
    const int gi = u & 15, rho = (u >> 4) & 15, bhd = u >> 8, b = bhd / 6, hd = bhd % 6, h = 4 + hd;
    const size_t bh = (size_t)(b * NH + h);
    const bf16_t* Qg = (const bf16_t*)(P.ws + OFF_Q) + bh * SEQ * 64;
    const bf16_t* Kg = (const bf16_t*)(P.ws + OFF_K) + bh * SEQ * 64;
    const bf16_t* VT = (const bf16_t*)(P.ws + OFF_V) + (size_t)(b * NVSLOT + 10 + hd * 3) * 64 * SEQ;
    const int pos = rho + 16 * (32 * gi + r);
    bf16x8 qf[4];
#pragma unroll
    for (int ks = 0; ks < 4; ++ks) qf[ks] = *(const bf16x8*)(Qg + (size_t)pos * 64 + 16 * ks + 8 * hh);
    f32x16 O[2];
#pragma unroll
    for (int dt = 0; dt < 2; ++dt)
#pragma unroll
        for (int g = 0; g < 16; ++g) O[dt][g] = 0.f;
    float m = -1e30f, l = 0.f;
    const float sl2 = 0.125f * 1.4426950408889634f;
    const int kslot = swap23(r);
    const int t0a = gi == 0 ? 4 : 0, t0c = gi < 4 ? 4 - gi : 0;
    const int na = 20 - t0a, nb = 8 - t0a, ntl = na + nb + 5 - t0c;
    const int r4 = rho & 3;
    auto ptrs = [&](int j, const bf16_t*& kp, const bf16_t*& vtp, int& start, int& mq) {
        if (j < na) { start = 512 * gi - 128 + 32 * (j + t0a); mq = pos; kp = Kg + (size_t)(start + kslot) * 64 + 8 * hh; vtp = VT + (size_t)r * SEQ + start + 8 * hh; }
        else if (j < na + nb) { start = 128 * (gi - 1) + 32 * (j - na + t0a); mq = (rho >> 2) + 128 * gi + 4 * r; kp = Kg + (size_t)((start + kslot) * 4 + r4) * 64 + 8 * hh; vtp = VT + (size_t)64 * SEQ + r4 * 2048 + (size_t)r * SEQ + start + 8 * hh; }
        else { start = 32 * gi - 128 + 32 * (j - na - nb + t0c); mq = 32 * gi + r; kp = Kg + (size_t)((start + kslot) * 16 + rho) * 64 + 8 * hh; vtp = VT + (size_t)128 * SEQ + rho * 512 + (size_t)r * SEQ + start + 8 * hh; }
    };
    bf16x8 kfA[4], vfA[2][2], kfB[4], vfB[2][2];
    int startA, mqA, startB = 0, mqB = 0;
    { const bf16_t* kp; const bf16_t* vtp; ptrs(0, kp, vtp, startA, mqA); wave_load(kp, vtp, (size_t)32 * SEQ, kfA, vfA); }
#pragma unroll 1
    for (int j = 0; j < ntl; j += 2) {
        if (j + 1 < ntl) { const bf16_t* kp; const bf16_t* vtp; ptrs(j + 1, kp, vtp, startB, mqB); wave_load(kp, vtp, (size_t)32 * SEQ, kfB, vfB); }
        wave_compute(kfA, vfA, qf, [&](int g) { const int dl = mqA - (startA + (g & 7) + 8 * hh + 16 * (g >> 3)); return dl >= 0 && dl <= 128; }, sl2, m, l, O);
        if (j + 1 < ntl) {
            if (j + 2 < ntl) { const bf16_t* kp; const bf16_t* vtp; ptrs(j + 2, kp, vtp, startA, mqA); wave_load(kp, vtp, (size_t)32 * SEQ, kfA, vfA); }
            wave_compute(kfB, vfB, qf, [&](int g) { const int dl = mqB - (startB + (g & 7) + 8 * hh + 16 * (g >> 3)); return dl >= 0 && dl <= 128; }, sl2, m, l, O);
        }
    }
    wave_store((bf16_t*)(P.ws + OFF_MIX) + (size_t)(b * SEQ + pos) * 1024 + h * 64, O, l, hh);
}
__device__ __forceinline__ void xattn_mfma_phase(const Params& P) {
    const int tid_ = opaque_tid(), lane = tid_ & 63, r = lane & 31, hh = lane >> 5, gw = blockIdx.x * 8 + (tid_ >> 6);
    const bf16_t* QM = (const bf16_t*)(P.ws + OFF_QM); const bf16_t* KM = (const bf16_t*)(P.ws + OFF_KMEM); const bf16_t* VMT = (const bf16_t*)(P.ws + OFF_VMEM);
    bf16_t* OM = (bf16_t*)(P.ws + OFF_OM);
    const float sl2 = 0.125f * 1.4426950408889634f;
    const int kslot = swap23(r);
    for (int u = gw; u < NTOK / 32 * 4; u += gridDim.x * 8) {
        const int h = u & 3, tok = (u >> 2) * 32 + r, b = tok >> 13;
        bf16x8 qf[4];
#pragma unroll
        for (int ks = 0; ks < 4; ++ks) qf[ks] = *(const bf16x8*)(QM + (size_t)tok * 256 + h * 64 + 16 * ks + 8 * hh);
        f32x16 O[2];
#pragma unroll
        for (int dt = 0; dt < 2; ++dt)
#pragma unroll
            for (int g = 0; g < 16; ++g) O[dt][g] = 0.f;
        float m = -1e30f, l = 0.f;
        const bf16_t* kp0 = KM + (size_t)(b * MEM_LEN + kslot) * 256 + h * 64 + 8 * hh;
        const bf16_t* vtp0 = VMT + ((size_t)(b * 4 + h) * 64 + r) * 256 + 8 * hh;
        bf16x8 kfA[4], vfA[2][2], kfB[4], vfB[2][2];
        wave_load(kp0, vtp0, (size_t)32 * 256, kfA, vfA);
#pragma unroll 1
        for (int tt = 0; tt < 8; tt += 2) {
            wave_load(kp0 + (size_t)(32 * tt + 32) * 256, vtp0 + 32 * tt + 32, (size_t)32 * 256, kfB, vfB);
            wave_compute(kfA, vfA, qf, [](int) { return true; }, sl2, m, l, O);
            if (tt + 2 < 8) wave_load(kp0 + (size_t)(32 * tt + 64) * 256, vtp0 + 32 * tt + 64, (size_t)32 * 256, kfA, vfA);
            wave_compute(kfB, vfB, qf, [](int) { return true; }, sl2, m, l, O);
        }
        wave_store(OM + (size_t)tok * 256 + h * 64, O, l, hh);
    }
}

constexpr size_t PA_REC = 136, OFF_PA0 = OFF_XN, OFF_PA1 = OFF_XN + (size_t)16 * 1024 * 1024;
static_assert((size_t)BATCH * 6 * SEQ * PA_REC <= (size_t)16 * 1024 * 1024, "PA overlay");
template <int BR>
__device__ __forceinline__ void attn_dilwin_unit(const Params& P, unsigned char* lds, int l_, int b, int hd, int res, int qb) {
    constexpr int D = BR == 0 ? 1 : (BR == 1 ? 4 : 16);
    const int tid = opaque_tid(), lane = tid & 63, wid = tid >> 6, r = lane & 31, hh = lane >> 5;
    const int h = 4 + hd;
    const size_t bh = (size_t)(b * NH + h);
    const bf16_t* Qg = (const bf16_t*)(P.ws + OFF_Q) + bh * SEQ * 64;
    const bf16_t* Kg = (const bf16_t*)(P.ws + OFF_K) + bh * SEQ * 64;
    const bf16_t* VTs = (const bf16_t*)(P.ws + OFF_V) + (size_t)(b * NVSLOT + 10 + hd * 3 + BR) * 64 * SEQ + res * (SEQ / D);
    const int q0 = qb * 256 + wid * 32, qi = q0 + r, pos = qi * D + res;
    bf16x8 qf[4];
#pragma unroll
    for (int ks = 0; ks < 4; ++ks) qf[ks] = *(const bf16x8*)(Qg + (size_t)pos * 64 + 16 * ks + 8 * hh);
    const float sl2 = 0.125f * 1.4426950408889634f;
    f32x16 O[2];
#pragma unroll
    for (int dt = 0; dt < 2; ++dt)
#pragma unroll
        for (int g = 0; g < 16; ++g) O[dt][g] = 0.f;
    float m = ((const float*)(P.ws + OFF_SB))[l_ * 4 + 2], l = 0.f;
    const int lrow = tid >> 3, lch = tid & 7;
    const int lwoff = lrow * AT_ROWB + lch * 16;
    const int tlo = qb == 0 ? 0 : 4 * qb - 2, thi = 4 * qb + 3;
    const bf16_t* kload = Kg + ((size_t)lrow * D + res) * 64 + lch * 8;
    const bf16_t* vload = VTs + (size_t)lrow * SEQ + lch * 8;
    uint4 kr = *(const uint4*)(kload + (size_t)tlo * 64 * D * 64), vr = *(const uint4*)(vload + tlo * 64);
    __syncthreads();
    *(uint4*)(lds + (tlo & 1) * AT_BUFB + lwoff) = kr; *(uint4*)(lds + (tlo & 1) * AT_BUFB + AT_TILEB + lwoff) = vr;
    __syncthreads();
    const int krow_off = swap23(r) * AT_ROWB + hh * 16, vrow_off = r * AT_ROWB + hh * 16;
#pragma unroll 1
    for (int t = tlo; t <= thi; ++t) {
        const int k0 = t * 64;
        if (t < thi) { kr = *(const uint4*)(kload + (size_t)(t + 1) * 64 * D * 64); vr = *(const uint4*)(vload + (t + 1) * 64); }
        if (k0 <= q0 + 31 && k0 + 63 >= q0 - 128) {
            const unsigned char* kb = lds + (t & 1) * AT_BUFB; const unsigned char* vb = kb + AT_TILEB;
            f32x16 xa[2];
#pragma unroll
            for (int sub = 0; sub < 2; ++sub) {
#pragma unroll
                for (int g = 0; g < 16; ++g) xa[sub][g] = 0.f;
#pragma unroll
                for (int ks = 0; ks < 4; ++ks) {
                    const bf16x8 kf = *(const bf16x8*)(kb + sub * 32 * AT_ROWB + krow_off + ks * 32);
                    xa[sub] = __builtin_amdgcn_mfma_f32_32x32x16_bf16(kf, qf[ks], xa[sub], 0, 0, 0);
                }
            }
            if (k0 + 63 > q0 || k0 < q0 + 31 - 128) {
#pragma unroll
                for (int sub = 0; sub < 2; ++sub)
#pragma unroll
                    for (int g = 0; g < 16; ++g) {
                        const int dl = qi - (k0 + sub * 32 + (g & 7) + 8 * hh + 16 * (g >> 3));
                        if (dl < 0 || dl > 128) xa[sub][g] = -INFINITY;
                    }
            }
            bf16x8 pa[2][2];
            osm_tile<true>(xa, sl2, m, l, O, pa);
#pragma unroll
            for (int dt = 0; dt < 2; ++dt)
#pragma unroll
                for (int sub = 0; sub < 2; ++sub)
#pragma unroll
                    for (int s2 = 0; s2 < 2; ++s2) {
                        const bf16x8 vf = *(const bf16x8*)(vb + dt * 32 * AT_ROWB + vrow_off + (sub * 32 + 16 * s2) * 2);
                        O[dt] = __builtin_amdgcn_mfma_f32_32x32x16_bf16(vf, pa[sub][s2], O[dt], 0, 0, 0);
                    }
        }
        if (t < thi) { unsigned char* wb = lds + ((t + 1) & 1) * AT_BUFB; *(uint4*)(wb + lwoff) = kr; *(uint4*)(wb + AT_TILEB + lwoff) = vr; }
        __syncthreads();
    }
    l += __shfl_xor(l, 32);
    const size_t rec = ((size_t)(b * 6 + hd) * SEQ + pos) * PA_REC;
    if (BR < 2) {
        unsigned char* pa = P.ws + (BR == 0 ? OFF_PA0 : OFF_PA1) + rec;
#pragma unroll
        for (int dt = 0; dt < 2; ++dt)
#pragma unroll
            for (int gq = 0; gq < 4; ++gq) {
                const int d = 32 * dt + 8 * gq + 4 * hh;
                uint2 w; w.x = pack2(O[dt][4 * gq], O[dt][4 * gq + 1]); w.y = pack2(O[dt][4 * gq + 2], O[dt][4 * gq + 3]);
                *(uint2*)(pa + 2 * d) = w;
            }
        if (hh == 0) { float2 ml; ml.x = m; ml.y = l; *(float2*)(pa + 128) = ml; }
    } else {
        const unsigned char* p0 = P.ws + OFF_PA0 + rec; const unsigned char* p1 = P.ws + OFF_PA1 + rec;
        const float2 ml0 = *(const float2*)(p0 + 128), ml1 = *(const float2*)(p1 + 128);
        const float mm = fmaxf(m, fmaxf(ml0.x, ml1.x));
        const float f0 = fexp2(ml0.x - mm), f1 = fexp2(ml1.x - mm), f2 = fexp2(m - mm);
        const float inv = 1.0f / (ml0.y * f0 + ml1.y * f1 + l * f2);
        bf16_t* dst = (bf16_t*)(P.ws + OFF_MIX) + (size_t)(b * SEQ + pos) * 1024 + h * 64;
#pragma unroll
        for (int dt = 0; dt < 2; ++dt)
#pragma unroll
            for (int gq = 0; gq < 4; ++gq) {
                const int d = 32 * dt + 8 * gq + 4 * hh;
                const uint2 a0 = *(const uint2*)(p0 + 2 * d), a1 = *(const uint2*)(p1 + 2 * d);
                const float o0 = (bflo(a0.x) * f0 + bflo(a1.x) * f1 + O[dt][4 * gq] * f2) * inv, o1 = (bfhi(a0.x) * f0 + bfhi(a1.x) * f1 + O[dt][4 * gq + 1] * f2) * inv;
                const float o2 = (bflo(a0.y) * f0 + bflo(a1.y) * f1 + O[dt][4 * gq + 2] * f2) * inv, o3 = (bfhi(a0.y) * f0 + bfhi(a1.y) * f1 + O[dt][4 * gq + 3] * f2) * inv;
                uint2 w; w.x = pack2(o0, o1); w.y = pack2(o2, o3);
                *(uint2*)(dst + d) = w;
            }
    }
}
__device__ __forceinline__ void dil01_phase(const Params& P, unsigned char* lds, int l_) {
    for (int u = blockIdx.x; u < 768; u += gridDim.x) {
        const int br = u / 384, v = u % 384, bhd = v >> 5, u32 = v & 31, b = bhd / 6, hd = bhd % 6;
        if (br == 0) attn_dilwin_unit<0>(P, lds, l_, b, hd, 0, u32);
        else attn_dilwin_unit<1>(P, lds, l_, b, hd, u32 >> 3, u32 & 7);
    }
}

__device__ __forceinline__ void xattn_block_phase(const Params& P, unsigned char* lds, int l_) {
    const int tid = opaque_tid(), lane = tid & 63, wid = tid >> 6, r = lane & 31, hh = lane >> 5;
    const bf16_t* QM = (const bf16_t*)(P.ws + OFF_QM); const bf16_t* KM = (const bf16_t*)(P.ws + OFF_KMEM); const bf16_t* VMT = (const bf16_t*)(P.ws + OFF_VMEM);
    bf16_t* OM = (bf16_t*)(P.ws + OFF_OM);
    const float sl2 = 0.125f * 1.4426950408889634f;
    const int lrow = tid >> 3, lch = tid & 7, lwoff = lrow * AT_ROWB + lch * 16;
    const int krow_off = swap23(r) * AT_ROWB + hh * 16, vrow_off = r * AT_ROWB + hh * 16;
    for (int u = blockIdx.x; u < (NTOK / 256) * 4; u += gridDim.x) {
        const int h = u & 3, tok = (u >> 2) * 256 + wid * 32 + r, b = (u >> 2) >> 5;
        bf16x8 qf[4];
#pragma unroll
        for (int ks = 0; ks < 4; ++ks) qf[ks] = *(const bf16x8*)(QM + (size_t)tok * 256 + h * 64 + 16 * ks + 8 * hh);
        f32x16 O[2];
#pragma unroll
        for (int dt = 0; dt < 2; ++dt)
#pragma unroll
            for (int g = 0; g < 16; ++g) O[dt][g] = 0.f;
        float m = ((const float*)(P.ws + OFF_SB))[l_ * 4 + 3], l = 0.f;
        const bf16_t* kload = KM + (size_t)(b * MEM_LEN + lrow) * 256 + h * 64 + lch * 8;
        const bf16_t* vload = VMT + ((size_t)(b * 4 + h) * 64 + lrow) * 256 + lch * 8;
        uint4 kr = *(const uint4*)kload, vr = *(const uint4*)vload;
        __syncthreads();
        *(uint4*)(lds + lwoff) = kr; *(uint4*)(lds + AT_TILEB + lwoff) = vr;
        __syncthreads();
#pragma unroll 1
        for (int t = 0; t < 4; ++t) {
            if (t < 3) { kr = *(const uint4*)(kload + (size_t)(t + 1) * 64 * 256); vr = *(const uint4*)(vload + (t + 1) * 64); }
            const unsigned char* kb = lds + (t & 1) * AT_BUFB; const unsigned char* vb = kb + AT_TILEB;
            f32x16 xa[2];
#pragma unroll
            for (int sub = 0; sub < 2; ++sub) {
#pragma unroll
                for (int g = 0; g < 16; ++g) xa[sub][g] = 0.f;
#pragma unroll
                for (int ks = 0; ks < 4; ++ks) {
                    const bf16x8 kf = *(const bf16x8*)(kb + sub * 32 * AT_ROWB + krow_off + ks * 32);
                    xa[sub] = __builtin_amdgcn_mfma_f32_32x32x16_bf16(kf, qf[ks], xa[sub], 0, 0, 0);
                }
            }
            bf16x8 pa[2][2];
            osm_tile<true>(xa, sl2, m, l, O, pa);
#pragma unroll
            for (int dt = 0; dt < 2; ++dt)
#pragma unroll
                for (int sub = 0; sub < 2; ++sub)
#pragma unroll
                    for (int s2 = 0; s2 < 2; ++s2) {
                        const bf16x8 vf = *(const bf16x8*)(vb + dt * 32 * AT_ROWB + vrow_off + (sub * 32 + 16 * s2) * 2);
                        O[dt] = __builtin_amdgcn_mfma_f32_32x32x16_bf16(vf, pa[sub][s2], O[dt], 0, 0, 0);
                    }
            if (t < 3) { unsigned char* wb = lds + ((t + 1) & 1) * AT_BUFB; *(uint4*)(wb + lwoff) = kr; *(uint4*)(wb + AT_TILEB + lwoff) = vr; }
            __syncthreads();
        }
        wave_store(OM + (size_t)tok * 256 + h * 64, O, l, hh);
    }
}

__device__ __forceinline__ void kmean_phase(const Params& P, unsigned char* lds) {
    const int tid = opaque_tid(), cg8 = tid & 7, rg = tid >> 3;
    float* red = (float*)lds;
    for (int u = blockIdx.x; u < 2 * 6 * 32; u += gridDim.x) {
        const int n = u & 31, bh = u >> 5, b = bh / 6, hm = bh % 6;
        const bf16_t* K = (const bf16_t*)(P.ws + OFF_K) + ((size_t)(b * NH + 10 + hm) * SEQ + n * 256) * 64;
        float acc[8];
#pragma unroll
        for (int i = 0; i < 8; ++i) acc[i] = 0.f;
#pragma unroll
        for (int p = 0; p < 4; ++p) {
            const uint4 w = *(const uint4*)(K + (size_t)(rg + 64 * p) * 64 + cg8 * 8);
            acc[0] += bflo(w.x); acc[1] += bfhi(w.x); acc[2] += bflo(w.y); acc[3] += bfhi(w.y); acc[4] += bflo(w.z); acc[5] += bfhi(w.z); acc[6] += bflo(w.w); acc[7] += bfhi(w.w);
        }
        __syncthreads();
#pragma unroll
        for (int i = 0; i < 8; ++i) red[rg * 64 + cg8 * 8 + i] = acc[i];
        __syncthreads();
        if (tid < 64) {
            float sum = 0.f;
            for (int g = 0; g < 64; ++g) sum += red[g * 64 + tid];
            ((float*)(P.ws + OFF_KMEAN))[(size_t)u * 64 + tid] = sum * (1.0f / 256.0f);
        }
    }
}

__device__ __forceinline__ void xattn_phase(const Params& P) {
    const int tid_ = opaque_tid(), lane = tid_ & 63, gw = blockIdx.x * 8 + (tid_ >> 6);
    const bf16_t* QM = (const bf16_t*)(P.ws + OFF_QM); const bf16_t* KM = (const bf16_t*)(P.ws + OFF_KMEM); const bf16_t* VM = (const bf16_t*)(P.ws + OFF_VMEM);
    bf16_t* OM = (bf16_t*)(P.ws + OFF_OM);
    for (int u = gw; u < NTOK * 4 / 64; u += gridDim.x * 8) {
        const int h = u & 3, tok = (u >> 2) * 64 + lane, b = tok >> 13;
        float q[64]; load_row64(QM + (size_t)tok * 256 + h * 64, q);
#pragma unroll
        for (int i = 0; i < 64; ++i) q[i] *= 0.125f;
        float O[64];
#pragma unroll
        for (int i = 0; i < 64; ++i) O[i] = 0.f;
        float m = -1e30f, lsum = 0.f;
#pragma unroll 1
        for (int j = 0; j < MEM_LEN; ++j) {
            const float sc = dotk<8>(KM + (size_t)(b * MEM_LEN + j) * 256 + h * 64, q);
            osm_update(sc, VM + (size_t)(b * MEM_LEN + j) * 256 + h * 64, m, lsum, O);
        }
        const float inv = 1.0f / lsum;
#pragma unroll
        for (int i = 0; i < 64; ++i) O[i] *= inv;
        store_row64(OM + (size_t)tok * 256 + h * 64, O);
    }
}

__device__ const unsigned short kUnitOrder[1024] = {992, 993, 994, 995, 996, 997, 998, 999, 960, 961, 962, 963, 964, 965, 966, 967, 928, 929, 930, 931, 932, 933, 934, 935, 896, 897, 898, 899, 900, 901, 902, 903, 864, 865, 866, 867, 868, 869, 870, 871, 832, 833, 834, 835, 836, 837, 838, 839, 800, 801, 802, 803, 804, 805, 806, 807, 768, 769, 770, 771, 772, 773, 774, 775, 736, 737, 738, 739, 740, 741, 742, 743, 704, 705, 706, 707, 708, 709, 710, 711, 672, 673, 674, 675, 676, 677, 678, 679, 640, 641, 642, 643, 644, 645, 646, 647, 608, 609, 610, 611, 612, 613, 614, 615, 576, 577, 578, 579, 580, 581, 582, 583, 1008, 1009, 1010, 1011, 1012, 1013, 1014, 1015, 1016, 1017, 1018, 1019, 544, 545, 546, 547, 548, 549, 550, 551, 976, 977, 978, 979, 980, 981, 982, 983, 984, 985, 986, 987, 944, 945, 946, 947, 948, 949, 950, 951, 952, 953, 954, 955, 512, 513, 514, 515, 516, 517, 518, 519, 912, 913, 914, 915, 916, 917, 918, 919, 920, 921, 922, 923, 480, 481, 482, 483, 484, 485, 486, 487, 880, 881, 882, 883, 884, 885, 886, 887, 888, 889, 890, 891, 848, 849, 850, 851, 852, 853, 854, 855, 856, 857, 858, 859, 448, 449, 450, 451, 452, 453, 454, 455, 816, 817, 818, 819, 820, 821, 822, 823, 824, 825, 826, 827, 784, 785, 786, 787, 788, 789, 790, 791, 792, 793, 794, 795, 416, 417, 418, 419, 420, 421, 422, 423, 752, 753, 754, 755, 756, 757, 758, 759, 760, 761, 762, 763, 720, 721, 722, 723, 724, 725, 726, 727, 728, 729, 730, 731, 384, 385, 386, 387, 388, 389, 390, 391, 688, 689, 690, 691, 692, 693, 694, 695, 696, 697, 698, 699, 352, 353, 354, 355, 356, 357, 358, 359, 656, 657, 658, 659, 660, 661, 662, 663, 664, 665, 666, 667, 624, 625, 626, 627, 628, 629, 630, 631, 632, 633, 634, 635, 320, 321, 322, 323, 324, 325, 326, 327, 592, 593, 594, 595, 596, 597, 598, 599, 600, 601, 602, 603, 560, 561, 562, 563, 564, 565, 566, 567, 568, 569, 570, 571, 288, 289, 290, 291, 292, 293, 294, 295, 528, 529, 530, 531, 532, 533, 534, 535, 536, 537, 538, 539, 496, 497, 498, 499, 500, 501, 502, 503, 504, 505, 506, 507, 256, 257, 258, 259, 260, 261, 262, 263, 464, 465, 466, 467, 468, 469, 470, 471, 472, 473, 474, 475, 224, 225, 226, 227, 228, 229, 230, 231, 432, 433, 434, 435, 436, 437, 438, 439, 440, 441, 442, 443, 400, 401, 402, 403, 404, 405, 406, 407, 408, 409, 410, 411, 192, 193, 194, 195, 196, 197, 198, 199, 368, 369, 370, 371, 372, 373, 374, 375, 376, 377, 378, 379, 336, 337, 338, 339, 340, 341, 342, 343, 344, 345, 346, 347, 160, 161, 162, 163, 164, 165, 166, 167, 304, 305, 306, 307, 308, 309, 310, 311, 312, 313, 314, 315, 272, 273, 274, 275, 276, 277, 278, 279, 280, 281, 282, 283, 128, 129, 130, 131, 132, 133, 134, 135, 240, 241, 242, 243, 244, 245, 246, 247, 248, 249, 250, 251, 96, 97, 98, 99, 100, 101, 102, 103, 208, 209, 210, 211, 212, 213, 214, 215, 216, 217, 218, 219, 176, 177, 178, 179, 180, 181, 182, 183, 184, 185, 186, 187, 64, 65, 66, 67, 68, 69, 70, 71, 144, 145, 146, 147, 148, 149, 150, 151, 152, 153, 154, 155, 112, 113, 114, 115, 116, 117, 118, 119, 120, 121, 122, 123, 32, 33, 34, 35, 36, 37, 38, 39, 80, 81, 82, 83, 84, 85, 86, 87, 88, 89, 90, 91, 48, 49, 50, 51, 52, 53, 54, 55, 56, 57, 58, 59, 0, 1, 2, 3, 4, 5, 6, 7, 32768, 32769, 32770, 32771, 32772, 32773, 32774, 32775, 32776, 32777, 32778, 32779, 32780, 32781, 32782, 32783, 32784, 32785, 32786, 32787, 32788, 32789, 32790, 32791, 32792, 32793, 32794, 32795, 32796, 32797, 32798, 32799, 32800, 32801, 32802, 32803, 32804, 32805, 32806, 32807, 32808, 32809, 32810, 32811, 32812, 32813, 32814, 32815, 32816, 32817, 32818, 32819, 32820, 32821, 32822, 32823, 32824, 32825, 32826, 32827, 32828, 32829, 32830, 32831, 32832, 32833, 32834, 32835, 32836, 32837, 32838, 32839, 32840, 32841, 32842, 32843, 32844, 32845, 32846, 32847, 32848, 32849, 32850, 32851, 32852, 32853, 32854, 32855, 32856, 32857, 32858, 32859, 32860, 32861, 32862, 32863, 32864, 32865, 32866, 32867, 32868, 32869, 32870, 32871, 32872, 32873, 32874, 32875, 32876, 32877, 32878, 32879, 32880, 32881, 32882, 32883, 32884, 32885, 32886, 32887, 32888, 32889, 32890, 32891, 32892, 32893, 32894, 32895, 32896, 32897, 32898, 32899, 32900, 32901, 32902, 32903, 32904, 32905, 32906, 32907, 32908, 32909, 32910, 32911, 32912, 32913, 32914, 32915, 32916, 32917, 32918, 32919, 32920, 32921, 32922, 32923, 32924, 32925, 32926, 32927, 32928, 32929, 32930, 32931, 32932, 32933, 32934, 32935, 32936, 32937, 32938, 32939, 32940, 32941, 32942, 32943, 32944, 32945, 32946, 32947, 32948, 32949, 32950, 32951, 32952, 32953, 32954, 32955, 32956, 32957, 32958, 32959, 32960, 32961, 32962, 32963, 32964, 32965, 32966, 32967, 32968, 32969, 32970, 32971, 32972, 32973, 32974, 32975, 32976, 32977, 32978, 32979, 32980, 32981, 32982, 32983, 32984, 32985, 32986, 32987, 32988, 32989, 32990, 32991, 32992, 32993, 32994, 32995, 32996, 32997, 32998, 32999, 33000, 33001, 33002, 33003, 33004, 33005, 33006, 33007, 33008, 33009, 33010, 33011, 33012, 33013, 33014, 33015, 33016, 33017, 33018, 33019, 33020, 33021, 33022, 33023, 33024, 33025, 33026, 33027, 33028, 33029, 33030, 33031, 33032, 33033, 33034, 33035, 33036, 33037, 33038, 33039, 33040, 33041, 33042, 33043, 33044, 33045, 33046, 33047, 33048, 33049, 33050, 33051, 33052, 33053, 33054, 33055, 33056, 33057, 33058, 33059, 33060, 33061, 33062, 33063, 33064, 33065, 33066, 33067, 33068, 33069, 33070, 33071, 33072, 33073, 33074, 33075, 33076, 33077, 33078, 33079, 33080, 33081, 33082, 33083, 33084, 33085, 33086, 33087, 33088, 33089, 33090, 33091, 33092, 33093, 33094, 33095, 33096, 33097, 33098, 33099, 33100, 33101, 33102, 33103, 33104, 33105, 33106, 33107, 33108, 33109, 33110, 33111, 33112, 33113, 33114, 33115, 33116, 33117, 33118, 33119, 33120, 33121, 33122, 33123, 33124, 33125, 33126, 33127, 33128, 33129, 33130, 33131, 33132, 33133, 33134, 33135, 33136, 33137, 33138, 33139, 33140, 33141, 33142, 33143, 33144, 33145, 33146, 33147, 33148, 33149, 33150, 33151, 16, 17, 18, 19, 20, 21, 22, 23, 24, 25, 26, 27};
__device__ __forceinline__ void attn_phase(const Params& P, unsigned char* lds, int l, unsigned* ctr) {
    const int tid = opaque_tid();
    constexpr int NUNITS = 1024;
    for (;;) {
        __syncthreads();
        if (tid == 0) *(int*)(lds + AT_QWORD) = (int)atomicAdd(ctr, 1u);
        __syncthreads();
        const int u = *(const int*)(lds + AT_QWORD);
        if (u >= NUNITS) break;
        const int code = kUnitOrder[u];
        if (code & 0x8000) { const int v = code & 0x7fff, bhd = v >> 5, u32 = v & 31; attn_dilwin_unit<2>(P, lds, l, bhd / 6, bhd % 6, u32 >> 1, u32 & 1); }
        else {
            const int qb = code >> 5, j = code & 15;
            if ((code & 16) == 0) attn_mfma_unit<0>(P, lds, l, j >> 2, j & 3, qb);
            else attn_mfma_unit<1>(P, lds, l, j / 6, 10 + j % 6, qb);
        }
    }
}


#define XB_TMO      128
#define XB_XCNT(j)  (256  + 64 * (j))
#define XB_XSUB(j)  (1280 + 64 * (j))
#define XB_XGEN(j)  (2304 + 64 * (j))
#define XB_TOP      3328
#define XB_TOPGEN   3392
#define XCD_BAR_WORDS 3456
#define XB_SPIN_CAP (1u << 18)
#define LAS __attribute__((address_space(3)))

__device__ __forceinline__ unsigned xb_ld(unsigned* p)              { return __hip_atomic_load(p, __ATOMIC_RELAXED, __HIP_MEMORY_SCOPE_AGENT); }
__device__ __forceinline__ unsigned xb_add(unsigned* p, unsigned v) { return __hip_atomic_fetch_add(p, v, __ATOMIC_RELAXED, __HIP_MEMORY_SCOPE_AGENT); }
__device__ __forceinline__ unsigned xb_xcc_id() { return (unsigned)__builtin_amdgcn_s_getreg((3 << 11) | 20) & 0xFu; }
#define XB_SPIN(cond, bar) do { unsigned _sp = 0; while (cond) { __builtin_amdgcn_s_sleep(1); \
    if ((++_sp & 255u) == 0u) { if (xb_ld(&(bar)[XB_TMO])) break; if (_sp > XB_SPIN_CAP) { atomicAdd(&(bar)[XB_TMO], 1u); break; } } } } while (0)

struct XcdBarrier {
    unsigned* bar; unsigned x;
    volatile LAS unsigned* st;
};

__device__ __forceinline__ XcdBarrier xcd_barrier_post(unsigned* bar, volatile LAS unsigned* st) {
    XcdBarrier b; b.bar = bar; b.x = xb_xcc_id(); b.st = st;
    if (threadIdx.x == 0) (void)xb_add(&bar[XB_XCNT(b.x)], 1u);
    return b;
}
__device__ __forceinline__ void xcd_barrier_complete(unsigned* bar, unsigned x, unsigned& nloc, unsigned& nx) {
    const unsigned G = gridDim.x * gridDim.y * gridDim.z;
    unsigned sum, cnt, mine, sp = 0u;
    for (;;) {
        sum = 0u; cnt = 0u; mine = 0u;
#pragma unroll
        for (unsigned j = 0; j < 16; ++j) { const unsigned c = xb_ld(&bar[XB_XCNT(j)]); sum += c; cnt += (c > 0u) ? 1u : 0u; mine = (j == x) ? c : mine; }
        if (sum == G) break;
        __builtin_amdgcn_s_sleep(1);
        if ((++sp & 255u) == 0u) { if (xb_ld(&bar[XB_TMO])) break; if (sp > XB_SPIN_CAP) { atomicAdd(&bar[XB_TMO], 1u); break; } }
    }
    nloc = mine > 0u ? mine : 1u; nx = cnt > 0u ? cnt : 1u;
}

__device__ __forceinline__ void xcd_barrier(const XcdBarrier& b) {
    asm volatile("s_waitcnt vmcnt(0)" ::: "memory");
    __syncthreads();
    if (threadIdx.x == 0) {
        unsigned* bar = b.bar;
        __builtin_amdgcn_s_waitcnt(0);
        unsigned nloc = b.st[0], nx = b.st[1];
        if (nloc == 0u) { xcd_barrier_complete(bar, b.x, nloc, nx); b.st[0] = nloc; b.st[1] = nx; }
        const unsigned old = xb_add(&bar[XB_XSUB(b.x)], 1u);
        const unsigned gen = old / nloc;
        if (old + 1u == (gen + 1u) * nloc) {
            __builtin_amdgcn_fence(__ATOMIC_RELEASE, "agent");
            asm volatile("s_waitcnt vmcnt(0)" ::: "memory");
            const unsigned og = xb_add(&bar[XB_TOP], 1u);
            const unsigned tg = og / nx;
            if (og + 1u == (tg + 1u) * nx) xb_add(&bar[XB_TOPGEN], 1u);
            else XB_SPIN(xb_ld(&bar[XB_TOPGEN]) == tg, bar);
            __builtin_amdgcn_fence(__ATOMIC_ACQUIRE, "agent");
            xb_add(&bar[XB_XGEN(b.x)], 1u);
            asm volatile("s_waitcnt vmcnt(0)" ::: "memory");
        } else {
            XB_SPIN(xb_ld(&bar[XB_XGEN(b.x)]) == gen, bar);
            __builtin_amdgcn_fence(__ATOMIC_ACQUIRE, "agent");
            asm volatile("s_waitcnt vmcnt(0)" ::: "memory");
        }
    }
    __syncthreads();
}

__device__ __forceinline__ void xcd_barrier_at(unsigned char* ws, volatile LAS unsigned* st) {
    XcdBarrier c; c.bar = (unsigned*)(ws + OFF_BAR); c.st = st; c.x = (unsigned)__builtin_amdgcn_readfirstlane((int)st[2]);
    xcd_barrier(c);
}
__device__ __forceinline__ int wmap(int map, int j) {
    if (map == 1) { const int c = j & 255; return (j & ~255) + 64 * ((c >> 5) & 3) + 32 * (c >> 7) + (c & 31); }
    if (map == 2) { const int t = j >> 8, c = j & 255; return c < 128 ? 128 * t + c : D_FF + 128 * t + (c - 128); }
    return j;
}
__device__ __forceinline__ void convert_weight(unsigned char* lds, const float* __restrict__ src, int ldw, int K, int N, bf16_t* __restrict__ dst, int map, int col0, int rot, const float* __restrict__ gk) {
    const int tid = opaque_tid();
    bf16_t* tile = (bf16_t*)lds;
    const int tk = K / 128, ntiles = (N / 64) * tk;
    const int kk = tid >> 4, n4 = (tid & 15) * 4, jr = tid >> 4, k8 = (tid & 15) * 8;
    int t = (int)((blockIdx.x + gridDim.x - (unsigned)rot % gridDim.x) % gridDim.x);
    float4 v[4];
    if (t < ntiles) {
        const int j0 = (t / tk) * 64, k0 = (t % tk) * 128, sc = col0 + wmap(map, j0 + (n4 & 32)) + (n4 & 31);
#pragma unroll
        for (int p = 0; p < 4; ++p) v[p] = *(const float4*)(src + (size_t)(k0 + p * 32 + kk) * ldw + sc);
    }
    for (; t < ntiles; t += gridDim.x) {
        const int j0 = (t / tk) * 64, k0 = (t % tk) * 128;
        __syncthreads();
#pragma unroll
        for (int p = 0; p < 4; ++p) {
            const float g = gk ? gk[k0 + p * 32 + kk] : 1.0f;
            tile[(n4 + 0) * 136 + p * 32 + kk] = f2bf(v[p].x * g); tile[(n4 + 1) * 136 + p * 32 + kk] = f2bf(v[p].y * g); tile[(n4 + 2) * 136 + p * 32 + kk] = f2bf(v[p].z * g); tile[(n4 + 3) * 136 + p * 32 + kk] = f2bf(v[p].w * g);
        }
        const int tn = t + gridDim.x;
        if (tn < ntiles) {
            const int j0n = (tn / tk) * 64, k0n = (tn % tk) * 128, sc = col0 + wmap(map, j0n + (n4 & 32)) + (n4 & 31);
#pragma unroll
            for (int p = 0; p < 4; ++p) v[p] = *(const float4*)(src + (size_t)(k0n + p * 32 + kk) * ldw + sc);
        }
        __syncthreads();
#pragma unroll
        for (int q = 0; q < 2; ++q) *(uint4*)(dst + (size_t)(j0 + jr + 32 * q) * K + k0 + k8) = *(const uint4*)(tile + (jr + 32 * q) * 136 + k8);
    }
}
__device__ __forceinline__ void xb_rows(const float* __restrict__ X, bf16_t* __restrict__ xb, float* __restrict__ part, int nrows) {
    const int tid_ = opaque_tid(), lane = tid_ & 63, wid = tid_ >> 6;
    for (int row = blockIdx.x * 8 + wid; row < nrows; row += gridDim.x * 8) {
        const float4* xp = (const float4*)(X + (size_t)row * 1024);
        float ss = 0.f;
#pragma unroll
        for (int i = 0; i < 4; ++i) {
            const float4 v = xp[lane + 64 * i]; ss += v.x * v.x + v.y * v.y + v.z * v.z + v.w * v.w;
            uint2 w; w.x = pack2(v.x, v.y); w.y = pack2(v.z, v.w);
            *(uint2*)(xb + (size_t)row * 1024 + (lane + 64 * i) * 4) = w;
        }
#pragma unroll
        for (int o = 32; o > 0; o >>= 1) ss += __shfl_xor(ss, o);
        if (lane < 16) part[(size_t)row * 16 + lane] = lane == 0 ? ss : 0.f;
    }
}
__device__ __forceinline__ void prologue_phase(const Params& P, unsigned char* lds) {
    int rot = 0;
    for (int l = 0; l < DEPTH; ++l) {
        bf16_t* wb = (bf16_t*)(P.ws + OFF_WB) + (size_t)l * WB_LAYER;
        convert_weight(lds, P.w_in + (size_t)l * 1024 * 3072, 3072, 1024, 2048, wb + WB_IN, 1, 0, rot, P.norm_mix + l * 1024); rot += 256;
        convert_weight(lds, P.w_in + (size_t)l * 1024 * 3072, 3072, 1024, 1024, wb + WB_IN + (size_t)2048 * 1024, 0, 2048, rot, P.norm_mix + l * 1024); rot += 128;
        convert_weight(lds, P.w_out + (size_t)l * 1024 * 1024, 1024, 1024, 1024, wb + WB_OUT, 0, 0, rot, nullptr); rot += 128;
        convert_weight(lds, P.w_mq + (size_t)l * 1024 * 256, 256, 1024, 256, wb + WB_MQ, 1, 0, rot, P.norm_cross + l * 1024); rot += 32;
        convert_weight(lds, P.w_mkv + (size_t)l * 1024 * 512, 512, 1024, 512, wb + WB_MKV, 1, 0, rot, nullptr); rot += 64;
        convert_weight(lds, P.w_mo + (size_t)l * 256 * 1024, 1024, 256, 1024, wb + WB_MO, 0, 0, rot, nullptr); rot += 32;
        convert_weight(lds, P.w_gu + (size_t)l * 1024 * 5632, 5632, 1024, 5632, wb + WB_GU, 2, 0, rot, P.norm_ffn + l * 1024); rot += 704;
        convert_weight(lds, P.w_down + (size_t)l * 2816 * 1024, 1024, 2816, 1024, wb + WB_DOWN, 0, 0, rot, nullptr); rot += 352;
        norm_rows(P.mem, P.norm_mem + l * 1024, (bf16_t*)(P.ws + OFF_MEMN) + (size_t)l * 512 * 1024, BATCH * MEM_LEN);
    }
    xb_rows(P.x, (bf16_t*)(P.ws + OFF_XN), (float*)(P.ws + OFF_PART), NTOK);
    float* cs = (float*)(P.ws + OFF_CS);
    for (int i = blockIdx.x * NTHREADS + opaque_tid(); i < NTOK * 8; i += gridDim.x * NTHREADS) {
        const int tok = i >> 3, f = i & 7;
        const float invf = (f == 0) ? 1.0f : (f == 1) ? 0.19392547244381735f : (f == 2) ? 0.037606030930863934f : (f == 3) ? 0.007292767314834156f :
                           (f == 4) ? 0.0014142135623730951f : (f == 5) ? 0.0002742520333386866f : (f == 6) ? 5.318295896944989e-05f : 1.0313530666425395e-05f;
        const float ang = (float)P.pos[tok] * invf;
        cs[2 * i] = cosf(ang); cs[2 * i + 1] = sinf(ang);
    }
}

__global__ void __launch_bounds__(NTHREADS, 2) fwd_megakernel(Params P) {
    extern __shared__ __attribute__((aligned(16))) unsigned char lds[];
    cg::grid_group grid = cg::this_grid();
    unsigned* ctrl = (unsigned*)(P.ws + OFF_CTRL);
    bf16_t* XN = (bf16_t*)(P.ws + OFF_XN);
    if (blockIdx.x == 0 && threadIdx.x < 8) {
        const int l = threadIdx.x >> 2, ty = threadIdx.x & 3, n = ty == 0 ? 32 : 64;
        const float* gq = ty == 0 ? P.qn_diff + l * 32 : ty == 1 ? P.qn_moba + l * 64 : ty == 2 ? P.qn_dil + l * 64 : P.qn_mem + l * 64;
        const float* gk = ty == 0 ? P.kn_diff + l * 32 : ty == 1 ? P.kn_moba + l * 64 : ty == 2 ? P.kn_dil + l * 64 : P.kn_mem + l * 64;
        float a = 0.f, b = 0.f;
        for (int i = 0; i < n; ++i) { a = fmaxf(a, fabsf(gq[i])); b = fmaxf(b, fabsf(gk[i])); }
        ((float*)(P.ws + OFF_SB))[threadIdx.x] = a * b * (float)n * (ty == 0 ? 0.17677669529663687f : 0.125f) * 1.4426950408889634f * 1.02f;
    }
    if (blockIdx.x == 0) {
        float* gt = (float*)(P.ws + OFF_GT);
        for (int i = threadIdx.x; i < 768; i += NTHREADS) {
            const int d = i & 63, ty = (i >> 6) % 3, wh = (i / 192) & 1, l = i / 384;
            float v = 0.f;
            if (ty == 0) { if (d < 32) v = (wh == 0 ? P.qn_diff : P.kn_diff)[l * 32 + d]; }
            else if (ty == 1) v = (wh == 0 ? P.qn_dil : P.kn_dil)[l * 64 + d];
            else v = (wh == 0 ? P.qn_moba : P.kn_moba)[l * 64 + d];
            gt[i] = v;
        }
    }
    volatile LAS unsigned* xbst = (volatile LAS unsigned*)((LAS unsigned char*)lds + 131072 + 64);
    if (threadIdx.x < 4) xbst[threadIdx.x] = 0u;
    __syncthreads();
    { XcdBarrier xb0 = xcd_barrier_post((unsigned*)(P.ws + OFF_BAR), xbst); if (threadIdx.x == 0) xbst[2] = xb0.x; }
    __syncthreads();
    prologue_phase(P, lds);
    if (P.ws == nullptr) grid.sync();
    xcd_barrier_at(P.ws, xbst);
    const float* PART = (const float*)(P.ws + OFF_PART);
    PG8_LAS unsigned char* glds = (PG8_LAS unsigned char*)lds;
    const int G = (int)gridDim.x, bx = (int)blockIdx.x;
    for (int l = 0; l < DEPTH; ++l) {
        const float* xin = (l == 0) ? P.x : P.out;
        const bf16_t* wb = (const bf16_t*)(P.ws + OFF_WB) + (size_t)l * WB_LAYER;
        {
            pg8::Gemm g{XN, wb + WB_IN, NTOK, 2048, 1024}; pg8::StaticOrder S; S.init(NTOK, 2048, G, bx);
            pg8::EpiQK e{(const float*)(P.ws + OFF_GT) + l * 384, (const float*)(P.ws + OFF_CS), (bf16_t*)(P.ws + OFF_Q), PART};
            pg8::gemm_phase<pg8::EpiQK, pg8::StaticOrder, true, true>(glds, g, S, e);
            pg8::Gemm g2{wb + WB_IN + (size_t)2048 * 1024, XN, 1024, NTOK, 1024}; pg8::StaticOrder S2; S2.init(1024, NTOK, G, bx);
            pg8::EpiVT e2{(bf16_t*)(P.ws + OFF_V), PART};
            pg8::gemm_phase<pg8::EpiVT, pg8::StaticOrder, true, true>(glds, g2, S2, e2);
        }
        xcd_barrier_at(P.ws, xbst);
        kmean_phase(P, lds);
        dil01_phase(P, lds, l);
        xcd_barrier_at(P.ws, xbst);
        attn_phase(P, lds, l, ctrl + 16 * l);
        xcd_barrier_at(P.ws, xbst);
        {
            pg8::Gemm g{(const bf16_t*)(P.ws + OFF_MIX), wb + WB_OUT, NTOK, 1024, 1024}; pg8::StaticOrder S; S.init(NTOK, 1024, G, bx);
            pg8::EpiResid2 e{xin, P.out, XN, (float*)(P.ws + OFF_PART)};
            pg8::gemm_phase<pg8::EpiResid2, pg8::StaticOrder, true, true>(glds, g, S, e);
        }
        xcd_barrier_at(P.ws, xbst);
        {
            pg8::Gemm g{XN, wb + WB_MQ, NTOK, 256, 1024}; pg8::StaticOrder S; S.init(NTOK, 256, G, bx);
            pg8::EpiHead2 e{P.qn_mem + l * 64, (bf16_t*)(P.ws + OFF_QM), nullptr, PART};
            pg8::gemm_phase<pg8::EpiHead2, pg8::StaticOrder, true, true>(glds, g, S, e);
            pg8::Gemm g2{(const bf16_t*)(P.ws + OFF_MEMN) + (size_t)l * 512 * 1024, wb + WB_MKV, 512, 512, 1024}; pg8::StaticOrder S2; S2.init(512, 512, G, (bx + G - 64) % G);
            pg8::EpiHead2 e2{P.kn_mem + l * 64, (bf16_t*)(P.ws + OFF_KMEM), (bf16_t*)(P.ws + OFF_VMEM), nullptr};
            pg8::gemm_phase<pg8::EpiHead2, pg8::StaticOrder, true, true>(glds, g2, S2, e2);
        }
        xcd_barrier_at(P.ws, xbst);
        xattn_block_phase(P, lds, l);
        xcd_barrier_at(P.ws, xbst);
        {
            pg8::Gemm g{(const bf16_t*)(P.ws + OFF_OM), wb + WB_MO, NTOK, 1024, 256}; pg8::StaticOrder S; S.init(NTOK, 1024, G, bx);
            pg8::EpiResid2 e{P.out, P.out, XN, (float*)(P.ws + OFF_PART)};
            pg8::gemm_phase<pg8::EpiResid2, pg8::StaticOrder, true, true>(glds, g, S, e);
        }
        xcd_barrier_at(P.ws, xbst);
        {
            pg8::Gemm g{XN, wb + WB_GU, NTOK, 2 * D_FF, 1024}; pg8::StaticOrder S; S.init(NTOK, 2 * D_FF, G, bx);
            pg8::EpiSwiglu2 e{(bf16_t*)(P.ws + OFF_H), PART};
            pg8::gemm_phase<pg8::EpiSwiglu2, pg8::StaticOrder, true, true>(glds, g, S, e);
        }
        xcd_barrier_at(P.ws, xbst);
        {
            pg8::Gemm g{(const bf16_t*)(P.ws + OFF_H), wb + WB_DOWN, NTOK, 1024, D_FF}; pg8::StaticOrder S; S.init(NTOK, 1024, G, bx);
            pg8::EpiResid2 e{P.out, P.out, (l + 1 < DEPTH) ? XN : nullptr, (float*)(P.ws + OFF_PART)};
            pg8::gemm_phase<pg8::EpiResid2, pg8::StaticOrder, true, true>(glds, g, S, e);
        }
        xcd_barrier_at(P.ws, xbst);
    }
}

extern "C" void kernel_launch(void* const* d_in, const int* in_sizes, int n_in, void* d_out, int out_size, void* d_ws, size_t ws_size, hipStream_t stream) {
    static int grid_blocks = 0;
    if (!grid_blocks) {
        int dev = 0, cus = 0, per_cu = 0;
        hipGetDevice(&dev);
        hipDeviceGetAttribute(&cus, hipDeviceAttributeMultiprocessorCount, dev);
        hipFuncSetAttribute((const void*)fwd_megakernel, hipFuncAttributeMaxDynamicSharedMemorySize, LDS_BYTES);
        hipOccupancyMaxActiveBlocksPerMultiprocessor(&per_cu, fwd_megakernel, NTHREADS, LDS_BYTES);
        if (per_cu < 1) per_cu = 1;
        if (per_cu > 1) per_cu = 1;
        grid_blocks = cus * per_cu;
    }
    Params p{};
    p.x = (const float*)d_in[0]; p.mem = (const float*)d_in[1]; p.pos = (const int*)d_in[2];
    p.norm_mix = (const float*)d_in[3]; p.w_in = (const float*)d_in[4]; p.qn_diff = (const float*)d_in[5]; p.kn_diff = (const float*)d_in[6];
    p.lq1 = (const float*)d_in[7]; p.lk1 = (const float*)d_in[8]; p.lq2 = (const float*)d_in[9]; p.lk2 = (const float*)d_in[10]; p.subln = (const float*)d_in[11];
    p.qn_dil = (const float*)d_in[12]; p.kn_dil = (const float*)d_in[13]; p.qn_moba = (const float*)d_in[14]; p.kn_moba = (const float*)d_in[15]; p.w_out = (const float*)d_in[16];
    p.norm_cross = (const float*)d_in[17]; p.norm_mem = (const float*)d_in[18]; p.w_mq = (const float*)d_in[19]; p.w_mkv = (const float*)d_in[20];
    p.qn_mem = (const float*)d_in[21]; p.kn_mem = (const float*)d_in[22]; p.w_mo = (const float*)d_in[23]; p.norm_ffn = (const float*)d_in[24];
    p.w_gu = (const float*)d_in[25]; p.w_down = (const float*)d_in[26];
    p.out = (float*)d_out; p.ws = (unsigned char*)d_ws;
    hipMemsetAsync(d_ws, 0, 32768, stream);
    void* args[] = {&p};
    hipError_t e = hipLaunchCooperativeKernel((const void*)fwd_megakernel, dim3(grid_blocks), dim3(NTHREADS), args, LDS_BYTES, stream);
    if (e != hipSuccess) fprintf(stderr, "cooperative launch failed: %s (grid %d)\n", hipGetErrorString(e), grid_blocks);
}
```

```cpp
#include <hip/hip_runtime.h>
#include <hip/hip_cooperative_groups.h>
#include <cstdio>
#include <cstdint>
namespace cg = cooperative_groups;

typedef unsigned short bf16_t;
typedef short bf16x8 __attribute__((ext_vector_type(8)));
typedef float f32x4 __attribute__((ext_vector_type(4)));

constexpr int D_MODEL = 1024, BATCH = 2, SEQ = 8192, DEPTH = 2, NTOK = BATCH * SEQ;
constexpr int NH = 16, HD = 64, D_FF = 2816, MEM_LEN = 256, MEMW = 256;
constexpr float EPS = 1e-6f;
constexpr int NTHREADS = 512;
constexpr int LDS_BYTES = 131072 + 256;

struct Params {
    const float* x; const float* mem; const int* pos;
    const float* norm_mix; const float* w_in; const float* qn_diff; const float* kn_diff;
    const float* lq1; const float* lk1; const float* lq2; const float* lk2; const float* subln;
    const float* qn_dil; const float* kn_dil; const float* qn_moba; const float* kn_moba; const float* w_out;
    const float* norm_cross; const float* norm_mem; const float* w_mq; const float* w_mkv;
    const float* qn_mem; const float* kn_mem; const float* w_mo; const float* norm_ffn;
    const float* w_gu; const float* w_down;
    float* out; unsigned char* ws;
};

constexpr size_t OFF_CTRL = 0;
constexpr size_t OFF_BAR  = 4096;
constexpr size_t OFF_XN   = 32768;
constexpr size_t OFF_MIX  = OFF_XN + (size_t)NTOK * 1024 * 2;
constexpr size_t OFF_PART = OFF_MIX + (size_t)NTOK * 1024 * 2;
constexpr size_t OFF_Q0   = OFF_PART + (size_t)NTOK * 16 * 4;
constexpr size_t OFF_Q    = OFF_Q0;
constexpr size_t OFF_K    = OFF_Q + (size_t)NTOK * 1024 * 2;
constexpr size_t OFF_V    = OFF_K + (size_t)NTOK * 1024 * 2;
constexpr int    NVSLOT   = 28;
constexpr size_t OFF_H    = OFF_Q;
constexpr size_t OFF_QM   = OFF_Q;
constexpr size_t OFF_OM   = OFF_K;
constexpr size_t OFF_MEMN = OFF_V + (size_t)BATCH * NVSLOT * 64 * SEQ * 2;
constexpr size_t OFF_KMEM = OFF_MEMN + (size_t)2 * 512 * 1024 * 2;
constexpr size_t OFF_VMEM = OFF_KMEM + (size_t)512 * 256 * 2;
constexpr size_t OFF_KMEAN= OFF_VMEM + (size_t)512 * 256 * 2;
constexpr size_t OFF_GT   = OFF_KMEAN + (size_t)2 * 6 * 32 * 64 * 4;
constexpr size_t OFF_SB   = OFF_GT + 2 * 2 * 3 * 64 * 4;
constexpr size_t OFF_CS   = OFF_SB + 256;
constexpr size_t OFF_WB   = OFF_CS + (size_t)NTOK * 16 * 4;
constexpr size_t WB_IN = 0, WB_OUT = WB_IN + (size_t)3072 * 1024, WB_MQ = WB_OUT + (size_t)1024 * 1024, WB_MKV = WB_MQ + (size_t)256 * 1024, WB_MO = WB_MKV + (size_t)512 * 1024,
                 WB_GU = WB_MO + (size_t)1024 * 256, WB_DOWN = WB_GU + (size_t)5632 * 1024, WB_LAYER = WB_DOWN + (size_t)1024 * 2816;
constexpr size_t WS_END   = OFF_WB + 2 * WB_LAYER * 2;
static_assert((size_t)NTOK * 2816 * 2 <= OFF_MEMN - OFF_Q, "h overlay");
static_assert(WS_END <= (size_t)268435456, "workspace");

__device__ __forceinline__ bf16_t f2bf(float f) { unsigned u = __float_as_uint(f); u += 0x7fffu + ((u >> 16) & 1u); return (bf16_t)(u >> 16); }
__device__ __forceinline__ float bf2f(bf16_t h) { return __uint_as_float(((unsigned)h) << 16); }
__device__ __forceinline__ float bflo(unsigned w) { return __uint_as_float(w << 16); }
__device__ __forceinline__ float bfhi(unsigned w) { return __uint_as_float(w & 0xffff0000u); }
typedef float f32x2c __attribute__((ext_vector_type(2)));
typedef __bf16 bf16x2c __attribute__((ext_vector_type(2)));
__device__ __forceinline__ unsigned pack2(float a, float b) { const f32x2c v = {a, b}; return __builtin_bit_cast(unsigned, __builtin_convertvector(v, bf16x2c)); }
__device__ __forceinline__ float fexp2(float x) { return __builtin_amdgcn_exp2f(x); }

__device__ __forceinline__ int opaque_tid() { int t = threadIdx.x; asm volatile("" : "+v"(t)); return t; }
__device__ __forceinline__ void norm_rows(const float* __restrict__ X, const float* __restrict__ g, bf16_t* __restrict__ out, int nrows) {
    const int tid_ = opaque_tid(), lane = tid_ & 63, wid = tid_ >> 6;
    for (int row = blockIdx.x * 8 + wid; row < nrows; row += gridDim.x * 8) {
        const float4* xp = (const float4*)(X + (size_t)row * 1024);
        float4 v[4]; float ss = 0.f;
#pragma unroll
        for (int i = 0; i < 4; ++i) { v[i] = xp[lane + 64 * i]; ss += v[i].x * v[i].x + v[i].y * v[i].y + v[i].z * v[i].z + v[i].w * v[i].w; }
#pragma unroll
        for (int o = 32; o > 0; o >>= 1) ss += __shfl_xor(ss, o);
        const float rstd = rsqrtf(ss * (1.0f / 1024.0f) + EPS);
#pragma unroll
        for (int i = 0; i < 4; ++i) {
            const float4 gg = ((const float4*)g)[lane + 64 * i];
            uint2 w; w.x = pack2(v[i].x * rstd * gg.x, v[i].y * rstd * gg.y); w.y = pack2(v[i].z * rstd * gg.z, v[i].w * rstd * gg.w);
            *(uint2*)(out + (size_t)row * 1024 + (lane + 64 * i) * 4) = w;
        }
    }
}

struct CmId { __device__ __forceinline__ int operator()(int c) const { return c; } };
struct CmGU { __device__ __forceinline__ int operator()(int c) const { const int t = c >> 7, w = c & 127; return w < 64 ? (64 * t + w) : (D_FF + 64 * t + (w - 64)); } };

template <class CM, class Epi>
__device__ __forceinline__ void gemm_run(unsigned char* lds, const bf16_t* __restrict__ A, int lda, const float* __restrict__ W, int ldw, int K, int mt, int nt, int first, CM cm, Epi epi) {
    const int tid = opaque_tid(), lane = tid & 63, wid = tid >> 6, wr = wid >> 1, wc = wid & 1, fr = lane & 15, fq = lane >> 4;
    bf16_t* sA = (bf16_t*)lds;
    bf16_t* sB = sA + 128 * 40;
    float* sC = (float*)lds;
    const int ntiles = mt * nt;
    const int arow = tid >> 2, akc = (tid & 3) * 8, bk = tid >> 4, bn8 = (tid & 15) * 8;
    for (int tile = first; tile < ntiles; tile += gridDim.x) {
        const int tm = tile / nt, tn = tile % nt, m0 = tm * 128, n0 = tn * 128;
        f32x4 acc[2][4];
#pragma unroll
        for (int m = 0; m < 2; ++m)
#pragma unroll
            for (int n = 0; n < 4; ++n) acc[m][n] = (f32x4){0.f, 0.f, 0.f, 0.f};
        const bf16_t* ap = A + (size_t)(m0 + arow) * lda + akc;
        const float* bp = W + (size_t)bk * ldw + cm(n0 + bn8);
        uint4 ra = *(const uint4*)ap; float4 rb0 = *(const float4*)bp, rb1 = *(const float4*)(bp + 4);
        const int nk = K / 32;
        for (int kt = 0; kt < nk; ++kt) {
            __syncthreads();
            *(uint4*)(sA + arow * 40 + akc) = ra;
            sB[(bn8 + 0) * 40 + bk] = f2bf(rb0.x); sB[(bn8 + 1) * 40 + bk] = f2bf(rb0.y); sB[(bn8 + 2) * 40 + bk] = f2bf(rb0.z); sB[(bn8 + 3) * 40 + bk] = f2bf(rb0.w);
            sB[(bn8 + 4) * 40 + bk] = f2bf(rb1.x); sB[(bn8 + 5) * 40 + bk] = f2bf(rb1.y); sB[(bn8 + 6) * 40 + bk] = f2bf(rb1.z); sB[(bn8 + 7) * 40 + bk] = f2bf(rb1.w);
            __syncthreads();
            if (kt + 1 < nk) { ap += 32; bp += (size_t)32 * ldw; ra = *(const uint4*)ap; rb0 = *(const float4*)bp; rb1 = *(const float4*)(bp + 4); }
            bf16x8 af[2], bfr[4];
#pragma unroll
            for (int m = 0; m < 2; ++m) af[m] = *(const bf16x8*)(sA + (wr * 32 + m * 16 + fr) * 40 + fq * 8);
#pragma unroll
            for (int n = 0; n < 4; ++n) bfr[n] = *(const bf16x8*)(sB + (wc * 64 + n * 16 + fr) * 40 + fq * 8);
#pragma unroll
            for (int m = 0; m < 2; ++m)
#pragma unroll
                for (int n = 0; n < 4; ++n) acc[m][n] = __builtin_amdgcn_mfma_f32_16x16x32_bf16(af[m], bfr[n], acc[m][n], 0, 0, 0);
        }
        __syncthreads();
#pragma unroll
        for (int m = 0; m < 2; ++m)
#pragma unroll
            for (int n = 0; n < 4; ++n)
#pragma unroll
                for (int j = 0; j < 4; ++j) sC[(wr * 32 + m * 16 + fq * 4 + j) * 132 + wc * 64 + n * 16 + fr] = acc[m][n][j];
        __syncthreads();
        epi(tm, tn, sC, tid);
    }
    __syncthreads();
}

struct EpiResid {
    const float* src; float* out;
    __device__ __forceinline__ void operator()(int tm, int tn, const float* sC, int tid) const {
        const int row = tid >> 2, c0 = (tid & 3) * 32;
        const size_t off = (size_t)(tm * 128 + row) * 1024 + tn * 128 + c0;
#pragma unroll
        for (int i = 0; i < 8; ++i) {
            const float4 s = *(const float4*)(src + off + i * 4); const float4 c = *(const float4*)(sC + row * 132 + c0 + i * 4);
            float4 o; o.x = s.x + c.x; o.y = s.y + c.y; o.z = s.z + c.z; o.w = s.w + c.w; *(float4*)(out + off + i * 4) = o;
        }
    }
};
struct EpiQKV {
    const int* pos; const float* gt;
    bf16_t* q;
    __device__ __forceinline__ void operator()(int tm, int tn, const float* sC, int tid) const {
        const int which = tn >> 3;
        if (which == 2) {
            const int col = tid & 127, tg = tid >> 7, hd = (tn & 7) * 2 + (col >> 6), d = col & 63;
            const int tok0 = tm * 128 + tg * 32, bb = tok0 >> 13, s0 = tok0 & 8191;
            bf16_t* vt = q + (size_t)2 * ((size_t)NTOK * 1024);
            const float* c = sC + (tg * 32) * 132 + col;
            const int ht = tn & 7;
            const int slot = ht < 2 ? hd : (ht >= 5 ? hd - 6 : 10 + (hd - 4) * 3);
            bf16_t* dstv = vt + ((size_t)(bb * NVSLOT + slot) * 64 + d) * SEQ;
#pragma unroll
            for (int i = 0; i < 4; ++i) {
                uint4 w; w.x = pack2(c[(8 * i) * 132], c[(8 * i + 1) * 132]); w.y = pack2(c[(8 * i + 2) * 132], c[(8 * i + 3) * 132]); w.z = pack2(c[(8 * i + 4) * 132], c[(8 * i + 5) * 132]); w.w = pack2(c[(8 * i + 6) * 132], c[(8 * i + 7) * 132]);
                *(uint4*)(dstv + s0 + i * 8) = w;
            }
            if (ht >= 2 && ht < 5) {
                bf16_t* d4 = dstv + (size_t)64 * SEQ; bf16_t* d16 = dstv + (size_t)2 * 64 * SEQ;
#pragma unroll
                for (int res = 0; res < 4; ++res) {
                    uint4 w; w.x = pack2(c[(res) * 132], c[(res + 4) * 132]); w.y = pack2(c[(res + 8) * 132], c[(res + 12) * 132]); w.z = pack2(c[(res + 16) * 132], c[(res + 20) * 132]); w.w = pack2(c[(res + 24) * 132], c[(res + 28) * 132]);
                    *(uint4*)(d4 + res * 2048 + (s0 >> 2)) = w;
                }
#pragma unroll
                for (int res = 0; res < 16; ++res) *(unsigned*)(d16 + res * 512 + (s0 >> 4)) = pack2(c[res * 132], c[(res + 16) * 132]);
            }
            return;
        }
        const int row = tid >> 2, hsel = (tid >> 1) & 1, half = tid & 1;
        const int head = (tn & 7) * 2 + hsel;
        const int tok = tm * 128 + row, b = tok >> 13, s = tok & 8191;
        float v32[32];
#pragma unroll
        for (int i = 0; i < 8; ++i) { const float4 c = *(const float4*)(sC + row * 132 + hsel * 64 + half * 32 + i * 4); v32[4 * i] = c.x; v32[4 * i + 1] = c.y; v32[4 * i + 2] = c.z; v32[4 * i + 3] = c.w; }
        bf16_t* dst = q + (size_t)which * ((size_t)NTOK * 1024) + ((size_t)(b * NH + head) * SEQ + s) * 64 + half * 32;
        if (which < 2) {
            float ss = 0.f;
#pragma unroll
            for (int i = 0; i < 32; ++i) ss += v32[i] * v32[i];
            const int ht = tn & 7; const bool diff = ht < 2;
            if (!diff) ss += __shfl_xor(ss, 1);
            const float rstd = rsqrtf(ss * (diff ? (1.0f / 32.0f) : (1.0f / 64.0f)) + EPS);
            const float* g = gt + (which * 3 + (ht < 2 ? 0 : ht < 5 ? 1 : 2)) * 64;
            const int goff = diff ? 0 : half * 32;
#pragma unroll
            for (int i = 0; i < 32; ++i) v32[i] = v32[i] * rstd * g[goff + i];
            const float p = (float)pos[tok];
            if (diff) {
#pragma unroll
                for (int i = 0; i < 4; ++i) {
                    const float invf = (i == 0) ? 1.0f : (i == 1) ? 0.037606030930863934f : (i == 2) ? 0.0014142135623730951f : 5.318295896944989e-05f;
                    const float ang = p * invf; const float cs = cosf(ang), sn = sinf(ang);
                    const float x1 = v32[i], x2 = v32[i + 4]; v32[i] = x1 * cs - x2 * sn; v32[i + 4] = x2 * cs + x1 * sn;
                }
            } else if (half == 0) {
#pragma unroll
                for (int i = 0; i < 8; ++i) {
                    const float invf = (i == 0) ? 1.0f : (i == 1) ? 0.19392547244381735f : (i == 2) ? 0.037606030930863934f : (i == 3) ? 0.007292767314834156f :
                                       (i == 4) ? 0.0014142135623730951f : (i == 5) ? 0.0002742520333386866f : (i == 6) ? 5.318295896944989e-05f : 1.0313530666425395e-05f;
                    const float ang = p * invf; const float cs = cosf(ang), sn = sinf(ang);
                    const float x1 = v32[i], x2 = v32[i + 8]; v32[i] = x1 * cs - x2 * sn; v32[i + 8] = x2 * cs + x1 * sn;
                }
            }
        }
#pragma unroll
        for (int i = 0; i < 4; ++i) {
            uint4 w; w.x = pack2(v32[8 * i], v32[8 * i + 1]); w.y = pack2(v32[8 * i + 2], v32[8 * i + 3]); w.z = pack2(v32[8 * i + 4], v32[8 * i + 5]); w.w = pack2(v32[8 * i + 6], v32[8 * i + 7]);
            *(uint4*)(dst + i * 8) = w;
        }
    }
};
struct EpiHeadNorm {
    const float* gain; bf16_t* out; int ldo; int norm_tiles; bf16_t* out2;
    __device__ __forceinline__ void operator()(int tm, int tn, const float* sC, int tid) const {
        const int row = tid >> 2, hsel = (tid >> 1) & 1, half = tid & 1;
        float v32[32];
#pragma unroll
        for (int i = 0; i < 8; ++i) { const float4 c = *(const float4*)(sC + row * 132 + hsel * 64 + half * 32 + i * 4); v32[4 * i] = c.x; v32[4 * i + 1] = c.y; v32[4 * i + 2] = c.z; v32[4 * i + 3] = c.w; }
        bf16_t* dst;
        if (tn < norm_tiles) {
            float ss = 0.f;
#pragma unroll
            for (int i = 0; i < 32; ++i) ss += v32[i] * v32[i];
            ss += __shfl_xor(ss, 1);
            const float rstd = rsqrtf(ss * (1.0f / 64.0f) + EPS);
#pragma unroll
            for (int i = 0; i < 32; ++i) v32[i] = v32[i] * rstd * gain[half * 32 + i];
            dst = out + (size_t)(tm * 128 + row) * ldo + tn * 128 + hsel * 64 + half * 32;
        } else {
            const int hd = (tn - norm_tiles) * 2 + hsel, mr = tm * 128 + row, bb = mr >> 8, mi = mr & 255;
#pragma unroll
            for (int i = 0; i < 32; ++i) out2[((size_t)(bb * 4 + hd) * 64 + half * 32 + i) * 256 + mi] = f2bf(v32[i]);
            return;
        }
#pragma unroll
        for (int i = 0; i < 4; ++i) {
            uint4 w; w.x = pack2(v32[8 * i], v32[8 * i + 1]); w.y = pack2(v32[8 * i + 2], v32[8 * i + 3]); w.z = pack2(v32[8 * i + 4], v32[8 * i + 5]); w.w = pack2(v32[8 * i + 6], v32[8 * i + 7]);
            *(uint4*)(dst + i * 8) = w;
        }
    }
};
struct EpiSwiglu {
    bf16_t* h;
    __device__ __forceinline__ void operator()(int tm, int tn, const float* sC, int tid) const {
        const int row = tid >> 2, c0 = (tid & 3) * 16;
        float o[16];
#pragma unroll
        for (int i = 0; i < 16; ++i) { const float g = sC[row * 132 + c0 + i], u = sC[row * 132 + 64 + c0 + i]; o[i] = g / (1.0f + __expf(-g)) * u; }
        bf16_t* dst = h + (size_t)(tm * 128 + row) * D_FF + tn * 64 + c0;
#pragma unroll
        for (int i = 0; i < 2; ++i) {
            uint4 w; w.x = pack2(o[8 * i], o[8 * i + 1]); w.y = pack2(o[8 * i + 2], o[8 * i + 3]); w.z = pack2(o[8 * i + 4], o[8 * i + 5]); w.w = pack2(o[8 * i + 6], o[8 * i + 7]);
            *(uint4*)(dst + i * 8) = w;
        }
    }
};

namespace pg8 {
#define PG8_LAS __attribute__((address_space(3)))
typedef unsigned short bf16_t;
typedef short bf16x8 __attribute__((ext_vector_type(8)));
typedef float f32x4 __attribute__((ext_vector_type(4)));
typedef unsigned u32x4 __attribute__((ext_vector_type(4)));
constexpr int BM = 256, BK = 64, HALF = 128, HTB = HALF * BK * 2  , STAGE_BYTES = 8 * HTB, NXCD = 8, WGM = 8;

__host__ __device__ __forceinline__ int lds_byte(int r, int c) { const int st = (r >> 4) * 2 + (c >> 5), rr = r & 15, cc = c & 31, ob = rr * 64 + cc * 2; return st * 1024 + (ob ^ (((ob >> 9) & 1) << 5)); }
__host__ __device__ __forceinline__ void stage_rc(int b, int& R, int& C) { const int st = b / 1024, sb = b % 1024, swz = sb ^ (((sb >> 9) & 1) << 5); R = (st >> 1) * 16 + swz / 64; C = (st & 1) * 32 + (swz % 64) / 2; }
__host__ __device__ __forceinline__ int perm32(int rho) { const int n = rho >> 4, i = rho & 15; return 8 * (i >> 2) + 4 * n + (i & 3); }

struct Unit { int pm, pn; };
struct Gemm { const bf16_t* A; const bf16_t* Bt; int M, N, K; };

struct StaticOrder {
    int nM, nN, nwg, G, c;
    __host__ __device__ void init(int M, int N, int G_, int c_) { nM = M / BM; nN = N / BM; nwg = nM * nN; G = G_; c = c_; }
    __host__ __device__ bool next(int i, Unit& u) const {
        const long L = (long)i * G + c; if (L >= nwg) return false;
        int wgid = (int)L; { const int q = nwg / NXCD, r = nwg % NXCD, xcd = wgid % NXCD, off = wgid / NXCD; wgid = (xcd < r ? xcd * (q + 1) : r * (q + 1) + (xcd - r) * q) + off; }
        const int nig = WGM * nN, gid = wgid / nig, fm = gid * WGM, gsz = (nM - fm) < WGM ? (nM - fm) : WGM;
        u.pm = fm + ((wgid % nig) % gsz); u.pn = (wgid % nig) / gsz; return true;
    }
    __device__ __forceinline__ void a_ready(const Unit&) const {}
    __device__ __forceinline__ void done(const Unit&) const {}
};

__device__ __forceinline__ unsigned cvt_pk_bf16(float lo, float hi) { const ::f32x2c v = {lo, hi}; return __builtin_bit_cast(unsigned, __builtin_convertvector(v, ::bf16x2c)); }
typedef unsigned u32x4 __attribute__((ext_vector_type(4)));
struct EpiResid2 {
    static constexpr bool PERM = false, AFTER_DRAIN = false;
    const float* src; float* out; bf16_t* xb; float* part;
    __device__ __forceinline__ void operator()(const f32x4 (&acc)[2][2][4][2], const Unit& u, int wr, int wc, int fr, int fq) const {
#pragma unroll
        for (int ai = 0; ai < 2; ++ai)
#pragma unroll
            for (int m = 0; m < 4; ++m) {
                const int row = u.pm * BM + ai * HALF + wr * 64 + m * 16 + fr;
                const size_t off = (size_t)row * 1024 + u.pn * BM + wc * 32 + 4 * fq;
                float ss = 0.f;
#pragma unroll
                for (int bj = 0; bj < 2; ++bj)
#pragma unroll
                    for (int n = 0; n < 2; ++n) {
                        const size_t o = off + bj * HALF + n * 16; const f32x4 sv = *(const f32x4*)(src + o); const f32x4 r = sv + acc[ai][bj][m][n];
                        *(f32x4*)(out + o) = r;
                        if (xb) { ss += r[0] * r[0] + r[1] * r[1] + r[2] * r[2] + r[3] * r[3]; uint2 w; w.x = cvt_pk_bf16(r[0], r[1]); w.y = cvt_pk_bf16(r[2], r[3]); *(uint2*)(xb + o) = w; }
                    }
                if (xb) {
                    ss += __shfl_xor(ss, 16); ss += __shfl_xor(ss, 32);
                    if (fq == 0) part[(size_t)row * 16 + u.pn * 4 + wc] = ss;
                }
            }
    }
};
__device__ __forceinline__ float row_rstd(const float* part, int row) {
    const f32x4* p = (const f32x4*)(part + (size_t)row * 16);
    const f32x4 a = p[0], b = p[1], c = p[2], d = p[3];
    const float ss = ((a[0] + a[1]) + (a[2] + a[3])) + ((b[0] + b[1]) + (b[2] + b[3])) + ((c[0] + c[1]) + (c[2] + c[3])) + ((d[0] + d[1]) + (d[2] + d[3]));
    float r = rsqrtf(ss * (1.0f / 1024.0f) + 1e-6f);
    asm volatile("" : "+v"(r) : : "memory");
    return r;
}
struct EpiQK {
    static constexpr bool PERM = true, AFTER_DRAIN = false;
    const float* gt; const float* cs; bf16_t* qk; const float* part;
    __device__ __forceinline__ void operator()(const f32x4 (&acc)[2][2][4][2], const Unit& u, int wr, int wc, int fr, int fq) const {
        const int which = u.pn >> 2, head = (u.pn & 3) * 4 + wc, type = head < 4 ? 0 : (head < 10 ? 1 : 2);
        const bool diff = type == 0;
        const float* g = gt + (which * 3 + type) * 64;
        f32x4 gv[2][2];
#pragma unroll
        for (int bj = 0; bj < 2; ++bj)
#pragma unroll
            for (int n = 0; n < 2; ++n) gv[bj][n] = *(const f32x4*)(g + (diff ? 0 : 32 * bj) + 8 * fq + 4 * n);
        bf16_t* base = qk + (size_t)which * ((size_t)16384 * 1024);
#pragma unroll
        for (int ai = 0; ai < 2; ++ai)
#pragma unroll
            for (int m = 0; m < 4; ++m) {
                const int tok = u.pm * BM + ai * HALF + wr * 64 + m * 16 + fr, b = tok >> 13, sp = tok & 8191;
                f32x4 v[2][2];
                const float rs0 = row_rstd(part, tok);
#pragma unroll
                for (int bj = 0; bj < 2; ++bj)
#pragma unroll
                    for (int n = 0; n < 2; ++n) v[bj][n] = acc[ai][bj][m][n] * rs0;
                const f32x4* cp = (const f32x4*)(cs + (size_t)tok * 16);
                const f32x4 c0 = cp[0], c1 = cp[1], c2 = cp[2], c3 = cp[3];
                if (diff) {
#pragma unroll
                    for (int bj = 0; bj < 2; ++bj) {
                        float ss = 0.f;
#pragma unroll
                        for (int n = 0; n < 2; ++n) ss += v[bj][n][0] * v[bj][n][0] + v[bj][n][1] * v[bj][n][1] + v[bj][n][2] * v[bj][n][2] + v[bj][n][3] * v[bj][n][3];
                        ss += __shfl_xor(ss, 16); ss += __shfl_xor(ss, 32);
                        const float rstd = rsqrtf(ss * (1.0f / 32.0f) + 1e-6f);
#pragma unroll
                        for (int n = 0; n < 2; ++n) v[bj][n] = v[bj][n] * rstd * gv[bj][n];
                        if (fq == 0) {
                            const float cc[4] = {c0[0], c1[0], c2[0], c3[0]}, sn[4] = {c0[1], c1[1], c2[1], c3[1]};
#pragma unroll
                            for (int e = 0; e < 4; ++e) { const float x1 = v[bj][0][e], x2 = v[bj][1][e]; v[bj][0][e] = x1 * cc[e] - x2 * sn[e]; v[bj][1][e] = x2 * cc[e] + x1 * sn[e]; }
                        }
                    }
                } else {
                    float ss = 0.f;
#pragma unroll
                    for (int bj = 0; bj < 2; ++bj)
#pragma unroll
                        for (int n = 0; n < 2; ++n) ss += v[bj][n][0] * v[bj][n][0] + v[bj][n][1] * v[bj][n][1] + v[bj][n][2] * v[bj][n][2] + v[bj][n][3] * v[bj][n][3];
                    ss += __shfl_xor(ss, 16); ss += __shfl_xor(ss, 32);
                    const float rstd = rsqrtf(ss * (1.0f / 64.0f) + 1e-6f);
#pragma unroll
                    for (int bj = 0; bj < 2; ++bj)
#pragma unroll
                        for (int n = 0; n < 2; ++n) v[bj][n] = v[bj][n] * rstd * gv[bj][n];
                    const float cc[8] = {c0[0], c0[2], c1[0], c1[2], c2[0], c2[2], c3[0], c3[2]}, sn[8] = {c0[1], c0[3], c1[1], c1[3], c2[1], c2[3], c3[1], c3[3]};
#pragma unroll
                    for (int n = 0; n < 2; ++n)
#pragma unroll
                        for (int e = 0; e < 4; ++e) {
                            const float mine = v[0][n][e], other = __shfl_xor(mine, 16);
                            const float sgn = fq == 0 ? -1.0f : 1.0f;
                            const float rot = mine * cc[4 * n + e] + sgn * other * sn[4 * n + e];
                            v[0][n][e] = fq < 2 ? rot : mine;
                        }
                }
                bf16_t* dst = base + ((size_t)(b * 16 + head) * 8192 + sp) * 64 + 8 * fq;
#pragma unroll
                for (int bj = 0; bj < 2; ++bj) {
                    u32x4 w; w.x = cvt_pk_bf16(v[bj][0][0], v[bj][0][1]); w.y = cvt_pk_bf16(v[bj][0][2], v[bj][0][3]); w.z = cvt_pk_bf16(v[bj][1][0], v[bj][1][1]); w.w = cvt_pk_bf16(v[bj][1][2], v[bj][1][3]);
                    *(u32x4*)(dst + 32 * bj) = w;
                }
            }
    }
};
struct EpiVT {
    static constexpr bool PERM = true, AFTER_DRAIN = false;
    bf16_t* vt; const float* part;
    __device__ __forceinline__ void operator()(const f32x4 (&acc)[2][2][4][2], const Unit& u, int wr, int wc, int fr, int fq) const {
        f32x4 rsa[2], rsc[2];
#pragma unroll
        for (int bj = 0; bj < 2; ++bj) {
            const int tok0 = u.pn * BM + bj * HALF + wc * 32 + 8 * fq;
#pragma unroll
            for (int e = 0; e < 4; ++e) { rsa[bj][e] = row_rstd(part, tok0 + e); rsc[bj][e] = row_rstd(part, tok0 + 4 + e); }
        }
#pragma unroll
        for (int ai = 0; ai < 2; ++ai) {
            const int head = u.pm * 4 + ai * 2 + wr;
            const bool dil = head >= 4 && head < 10;
            const int slot = head < 4 ? head : (head >= 10 ? head - 6 : 10 + (head - 4) * 3);
#pragma unroll
            for (int m = 0; m < 4; ++m) {
                const int d = m * 16 + fr;
#pragma unroll
                for (int bj = 0; bj < 2; ++bj) {
                    const int tok0 = u.pn * BM + bj * HALF + wc * 32 + 8 * fq, b = tok0 >> 13, sp = tok0 & 8191;
                    const f32x4 a = acc[ai][bj][m][0] * rsa[bj], c = acc[ai][bj][m][1] * rsc[bj];
                    bf16_t* dst = vt + ((size_t)(b * 28 + slot) * 64 + d) * 8192;
                    u32x4 w; w.x = cvt_pk_bf16(a[0], a[1]); w.y = cvt_pk_bf16(a[2], a[3]); w.z = cvt_pk_bf16(c[0], c[1]); w.w = cvt_pk_bf16(c[2], c[3]);
                    *(u32x4*)(dst + sp) = w;
                    if (dil) {
                        bf16_t* d4 = dst + (size_t)64 * 8192; bf16_t* d16 = dst + (size_t)128 * 8192;
#pragma unroll
                        for (int e = 0; e < 4; ++e) *(unsigned*)(d4 + e * 2048 + (sp >> 2)) = cvt_pk_bf16(a[e], c[e]);
#pragma unroll
                        for (int e = 0; e < 4; ++e) {
                            const unsigned pa = cvt_pk_bf16(a[e], c[e]);
                            d16[((sp & 15) + e) * 512 + (sp >> 4)] = (bf16_t)(pa & 0xffffu);
                            d16[((sp & 15) + e + 4) * 512 + (sp >> 4)] = (bf16_t)(pa >> 16);
                        }
                    }
                }
            }
        }
    }
};
struct EpiHead2 {
    static constexpr bool PERM = true, AFTER_DRAIN = false;
    const float* gain; bf16_t* out; bf16_t* vmt; const float* part;
    __device__ __forceinline__ void operator()(const f32x4 (&acc)[2][2][4][2], const Unit& u, int wr, int wc, int fr, int fq) const {
        f32x4 gv[2][2];
#pragma unroll
        for (int bj = 0; bj < 2; ++bj)
#pragma unroll
            for (int n = 0; n < 2; ++n) gv[bj][n] = *(const f32x4*)(gain + 32 * bj + 8 * fq + 4 * n);
#pragma unroll
        for (int ai = 0; ai < 2; ++ai)
#pragma unroll
            for (int m = 0; m < 4; ++m) {
                const int row = u.pm * BM + ai * HALF + wr * 64 + m * 16 + fr;
                if (u.pn == 0) {
                    const float rs0 = part ? row_rstd(part, row) : 1.0f;
                    float ss = 0.f;
#pragma unroll
                    for (int bj = 0; bj < 2; ++bj)
#pragma unroll
                        for (int n = 0; n < 2; ++n) { const f32x4 x = acc[ai][bj][m][n] * rs0; ss += x[0] * x[0] + x[1] * x[1] + x[2] * x[2] + x[3] * x[3]; }
                    ss += __shfl_xor(ss, 16); ss += __shfl_xor(ss, 32);
                    const float rstd = rsqrtf(ss * (1.0f / 64.0f) + 1e-6f) * rs0;
                    bf16_t* dst = out + (size_t)row * 256 + 64 * wc + 8 * fq;
#pragma unroll
                    for (int bj = 0; bj < 2; ++bj) {
                        const f32x4 x0 = acc[ai][bj][m][0] * rstd * gv[bj][0], x1 = acc[ai][bj][m][1] * rstd * gv[bj][1];
                        u32x4 w; w.x = cvt_pk_bf16(x0[0], x0[1]); w.y = cvt_pk_bf16(x0[2], x0[3]); w.z = cvt_pk_bf16(x1[0], x1[1]); w.w = cvt_pk_bf16(x1[2], x1[3]);
                        *(u32x4*)(dst + 32 * bj) = w;
                    }
                } else {
                    const int b = row >> 8, mi = row & 255;
#pragma unroll
                    for (int bj = 0; bj < 2; ++bj)
#pragma unroll
                        for (int n = 0; n < 2; ++n)
#pragma unroll
                            for (int e = 0; e < 4; ++e) {
                                const unsigned pk = cvt_pk_bf16(acc[ai][bj][m][n][e], 0.f);
                                vmt[((size_t)(b * 4 + wc) * 64 + 32 * bj + 8 * fq + 4 * n + e) * 256 + mi] = (bf16_t)(pk & 0xffffu);
                            }
                }
            }
    }
};
struct EpiSwiglu2 {
    static constexpr bool PERM = true, AFTER_DRAIN = false;
    bf16_t* h; const float* part;
    __device__ __forceinline__ void operator()(const f32x4 (&acc)[2][2][4][2], const Unit& u, int wr, int wc, int fr, int fq) const {
#pragma unroll
        for (int ai = 0; ai < 2; ++ai)
#pragma unroll
            for (int m = 0; m < 4; ++m) {
                const int row = u.pm * BM + ai * HALF + wr * 64 + m * 16 + fr;
                const float rs0 = row_rstd(part, row);
                float o[8];
#pragma unroll
                for (int n = 0; n < 2; ++n)
#pragma unroll
                    for (int e = 0; e < 4; ++e) { const float g = acc[ai][0][m][n][e] * rs0, up = acc[ai][1][m][n][e] * rs0; o[4 * n + e] = g * __builtin_amdgcn_rcpf(1.0f + __expf(-g)) * up; }
                u32x4 w; w.x = cvt_pk_bf16(o[0], o[1]); w.y = cvt_pk_bf16(o[2], o[3]); w.z = cvt_pk_bf16(o[4], o[5]); w.w = cvt_pk_bf16(o[6], o[7]);
                *(u32x4*)(h + (size_t)row * 2816 + u.pn * 128 + wc * 32 + 8 * fq) = w;
            }
    }
};
template <class Epi, class Sched, bool ALIGN_EPI = false, bool SP2 = false>
__device__ __forceinline__ void gemm_phase(PG8_LAS unsigned char* lds, const Gemm g, const Sched& S, const Epi& E) {
    const int tid = opaque_tid(), wid = __builtin_amdgcn_readfirstlane(tid >> 6), lane = tid & 63, wr = wid >> 2, wc = wid & 3, fr = lane & 15, fq = lane >> 4;
    const int K = g.K, nt = K / BK;
    unsigned voffA[2], voffB[2];
#pragma unroll
    for (int i = 0; i < 2; ++i) { int R, C; stage_rc(tid * 16 + i * 8192, R, C); const int Rb = Epi::PERM ? ((R & ~31) + perm32(R & 31)) : R;
        voffA[i] = (unsigned)(R * K + C) * 2u; voffB[i] = (unsigned)(Rb * K + C) * 2u; }
    const size_t kstep = (size_t)(BK * 2);
    const size_t hstep = (size_t)HALF * K * 2;
    const size_t tstep = 2 * hstep;
    const unsigned ldsw = (unsigned)wid * 1024u;
    const int aoff = lds_byte(wr * 64 + fr, fq * 8), boff = lds_byte(wc * 32 + fr, fq * 8);
#define PG8_SA(b, h) (((b) * 2 + (h)) * HTB)
#define PG8_SB(b, h) ((4 + (b) * 2 + (h)) * HTB)
#define PG8_STAGE(bufoff, gbase, voff) do { _Pragma("unroll") for (int _i = 0; _i < 2; ++_i) \
        __builtin_amdgcn_global_load_lds((const unsigned*)((const char*)(gbase) + (voff)[_i]), (PG8_LAS unsigned*)(lds + (bufoff) + ldsw + _i * 8192), 16, 0, 0); } while (0)
#define PG8_LDA(dst, b, h) do { _Pragma("unroll") for (int m = 0; m < 4; ++m) _Pragma("unroll") for (int k = 0; k < 2; ++k) dst[m][k] = *(const PG8_LAS bf16x8*)(lds + PG8_SA(b, h) + aoff + m * 2048 + k * 1024); } while (0)
#define PG8_LDB(dst, b, h) do { _Pragma("unroll") for (int n = 0; n < 2; ++n) _Pragma("unroll") for (int k = 0; k < 2; ++k) dst[n][k] = *(const PG8_LAS bf16x8*)(lds + PG8_SB(b, h) + boff + n * 2048 + k * 1024); } while (0)
#define PG8_MMA(ai, bj, At, Bt) do { __builtin_amdgcn_s_setprio(1); _Pragma("unroll") for (int m = 0; m < 4; ++m) _Pragma("unroll") for (int n = 0; n < 2; ++n) _Pragma("unroll") for (int k = 0; k < 2; ++k) \
        acc[ai][bj][m][n] = __builtin_amdgcn_mfma_f32_16x16x32_bf16(Bt[n][k], At[m][k], acc[ai][bj][m][n], 0, 0, 0); __builtin_amdgcn_s_setprio(0); } while (0)
#define PG8_WAIT_V(n) asm volatile("s_waitcnt vmcnt(" #n ")" ::: "memory")
#define PG8_WAIT_L(n) asm volatile("s_waitcnt lgkmcnt(" #n ")" ::: "memory")
#define PG8_BAR __builtin_amdgcn_s_barrier()
#define PG8_SCHED __builtin_amdgcn_sched_barrier(0)
    Unit cur, nxt; int ui = 0;
    if (!S.next(0, cur)) return;
    f32x4 acc[2][2][4][2];
#pragma unroll
    for (int a = 0; a < 2; ++a)
#pragma unroll
        for (int b = 0; b < 2; ++b)
#pragma unroll
            for (int m = 0; m < 4; ++m)
#pragma unroll
                for (int n = 0; n < 2; ++n) acc[a][b][m][n] = (f32x4){0.f, 0.f, 0.f, 0.f};
    bf16x8 At[4][2], B0[2][2], B1[2][2];
    const char* cA = (const char*)g.A + (size_t)cur.pm * tstep; const char* cB = (const char*)g.Bt + (size_t)cur.pn * tstep;
    S.a_ready(cur);
    if constexpr (SP2) {
        PG8_STAGE(PG8_SB(0, 0), cB, voffB); PG8_STAGE(PG8_SB(0, 1), cB + hstep, voffB); PG8_STAGE(PG8_SA(0, 0), cA, voffA); PG8_STAGE(PG8_SA(0, 1), cA + hstep, voffA);
        if (wr == 1) PG8_BAR;
        PG8_WAIT_V(2); PG8_BAR;
        PG8_STAGE(PG8_SB(1, 0), cB + kstep, voffB); PG8_STAGE(PG8_SA(1, 0), cA + kstep, voffA); PG8_STAGE(PG8_SB(1, 1), cB + hstep + kstep, voffB);
        PG8_WAIT_V(6); PG8_BAR;
    } else {
        PG8_STAGE(PG8_SB(0, 0), cB, voffB); PG8_STAGE(PG8_SA(0, 0), cA, voffA); PG8_STAGE(PG8_SB(0, 1), cB + hstep, voffB); PG8_STAGE(PG8_SA(0, 1), cA + hstep, voffA);
        if (wr == 1) PG8_BAR;
        PG8_WAIT_V(4); PG8_BAR;
        PG8_STAGE(PG8_SB(1, 0), cB + kstep, voffB); PG8_STAGE(PG8_SA(1, 0), cA + kstep, voffA); PG8_STAGE(PG8_SB(1, 1), cB + hstep + kstep, voffB);
        PG8_WAIT_V(6); PG8_BAR;
    }
    for (;;) {
        const bool has_next = S.next(ui + 1, nxt);
        const char* nA = has_next ? (const char*)g.A + (size_t)nxt.pm * tstep : cA; const char* nB = has_next ? (const char*)g.Bt + (size_t)nxt.pn * tstep : cB;
        for (int t = 0; t < nt; t += 2) {
            const bool last = (t == nt - 2);
            const char* a1 = cA + (size_t)(t + 1) * kstep;
            const char* a2 = last ? nA : cA + (size_t)(t + 2) * kstep; const char* b2 = last ? nB : cB + (size_t)(t + 2) * kstep;
            const char* a3 = a2 + kstep; const char* b3 = b2 + kstep;
            if (last && has_next) S.a_ready(nxt);
            if constexpr (SP2) {
            PG8_LDB(B0, 0, 0); PG8_LDB(B1, 0, 1); PG8_SCHED; PG8_LDA(At, 0, 0); PG8_STAGE(PG8_SA(1, 1), a1 + hstep, voffA);
            PG8_WAIT_V(8); PG8_WAIT_L(0); PG8_BAR; PG8_MMA(0, 0, At, B0); PG8_MMA(0, 1, At, B1); PG8_BAR; PG8_SCHED;
            PG8_LDA(At, 0, 1); PG8_STAGE(PG8_SB(0, 0), b2, voffB); PG8_STAGE(PG8_SB(0, 1), b2 + hstep, voffB); PG8_STAGE(PG8_SA(0, 0), a2, voffA);
            PG8_WAIT_V(8); PG8_WAIT_L(0); PG8_BAR; PG8_MMA(1, 0, At, B0); PG8_MMA(1, 1, At, B1); PG8_BAR; PG8_SCHED;
            PG8_LDB(B0, 1, 0); PG8_LDB(B1, 1, 1); PG8_SCHED; PG8_LDA(At, 1, 0); PG8_STAGE(PG8_SA(0, 1), a2 + hstep, voffA);
            PG8_WAIT_V(8); PG8_WAIT_L(0); PG8_BAR; PG8_MMA(0, 0, At, B0); PG8_MMA(0, 1, At, B1); PG8_BAR; PG8_SCHED;
            PG8_LDA(At, 1, 1); PG8_STAGE(PG8_SB(1, 0), b3, voffB); PG8_STAGE(PG8_SB(1, 1), b3 + hstep, voffB); PG8_STAGE(PG8_SA(1, 0), a3, voffA);
            PG8_WAIT_V(8); PG8_WAIT_L(0); PG8_BAR; PG8_MMA(1, 0, At, B0); PG8_MMA(1, 1, At, B1); PG8_BAR; PG8_SCHED;
            } else {
            PG8_LDB(B0, 0, 0); PG8_SCHED; PG8_LDA(At, 0, 0); PG8_STAGE(PG8_SA(1, 1), a1 + hstep, voffA);
            PG8_WAIT_L(8); PG8_BAR; PG8_WAIT_L(0); PG8_MMA(0, 0, At, B0); PG8_BAR; PG8_SCHED;
            PG8_LDB(B1, 0, 1); PG8_STAGE(PG8_SB(0, 0), b2, voffB);
            PG8_BAR; PG8_WAIT_L(0); PG8_MMA(0, 1, At, B1); PG8_BAR;
            PG8_LDA(At, 0, 1); PG8_STAGE(PG8_SA(0, 0), a2, voffA);
            PG8_BAR; PG8_WAIT_L(0); PG8_MMA(1, 0, At, B0); PG8_BAR; PG8_SCHED;
            PG8_STAGE(PG8_SB(0, 1), b2 + hstep, voffB);
            PG8_WAIT_V(6); PG8_BAR; PG8_MMA(1, 1, At, B1); PG8_BAR;
            PG8_LDB(B0, 1, 0); PG8_SCHED; PG8_LDA(At, 1, 0); PG8_STAGE(PG8_SA(0, 1), a2 + hstep, voffA);
            PG8_WAIT_L(8); PG8_BAR; PG8_WAIT_L(0); PG8_MMA(0, 0, At, B0); PG8_BAR; PG8_SCHED;
            PG8_LDB(B1, 1, 1); PG8_STAGE(PG8_SB(1, 0), b3, voffB);
            PG8_BAR; PG8_WAIT_L(0); PG8_MMA(0, 1, At, B1); PG8_BAR;
            PG8_LDA(At, 1, 1); PG8_STAGE(PG8_SA(1, 0), a3, voffA);
            PG8_BAR; PG8_WAIT_L(0); PG8_MMA(1, 0, At, B0); PG8_BAR; PG8_SCHED;
            PG8_STAGE(PG8_SB(1, 1), b3 + hstep, voffB);
            PG8_WAIT_V(6); PG8_BAR; PG8_MMA(1, 1, At, B1); PG8_BAR;
            }
        }
        if constexpr (ALIGN_EPI) { if (wr == 0) PG8_BAR; }
        if constexpr (!Epi::AFTER_DRAIN) { E(acc, cur, wr, wc, fr, fq); S.done(cur); }
        if (!has_next) break;
#pragma unroll
        for (int a = 0; a < 2; ++a)
#pragma unroll
            for (int b = 0; b < 2; ++b)
#pragma unroll
                for (int m = 0; m < 4; ++m)
#pragma unroll
                    for (int n = 0; n < 2; ++n) acc[a][b][m][n] = (f32x4){0.f, 0.f, 0.f, 0.f};
        cur = nxt; cA = nA; cB = nB; ++ui;
        if constexpr (ALIGN_EPI) { if (wr == 1) PG8_BAR; }
    }
    PG8_WAIT_V(0);
    if constexpr (!ALIGN_EPI) { if (wr == 0) PG8_BAR; }
    PG8_BAR;
    if constexpr (Epi::AFTER_DRAIN) { E.fused(acc, cur, wr, wc, fr, fq, lds, wid, lane); S.done(cur); }
#undef PG8_SA
#undef PG8_SB
#undef PG8_STAGE
#undef PG8_LDA
#undef PG8_LDB
#undef PG8_MMA
#undef PG8_WAIT_V
#undef PG8_WAIT_L
#undef PG8_BAR
#undef PG8_SCHED
}
}

__device__ __forceinline__ void load_row64(const bf16_t* p, float* f) {
#pragma unroll
    for (int i = 0; i < 8; ++i) { const uint4 w = ((const uint4*)p)[i]; f[8 * i] = bflo(w.x); f[8 * i + 1] = bfhi(w.x); f[8 * i + 2] = bflo(w.y); f[8 * i + 3] = bfhi(w.y); f[8 * i + 4] = bflo(w.z); f[8 * i + 5] = bfhi(w.z); f[8 * i + 6] = bflo(w.w); f[8 * i + 7] = bfhi(w.w); }
}
__device__ __forceinline__ void store_row64(bf16_t* p, const float* f) {
#pragma unroll
    for (int i = 0; i < 8; ++i) { uint4 w; w.x = pack2(f[8 * i], f[8 * i + 1]); w.y = pack2(f[8 * i + 2], f[8 * i + 3]); w.z = pack2(f[8 * i + 4], f[8 * i + 5]); w.w = pack2(f[8 * i + 6], f[8 * i + 7]); ((uint4*)p)[i] = w; }
}
template <int NCH> __device__ __forceinline__ float dotk(const bf16_t* kp, const float* q) {
    float s = 0.f;
#pragma unroll
    for (int c = 0; c < NCH; ++c) { const uint4 w = ((const uint4*)kp)[c];
        s += q[8 * c] * bflo(w.x) + q[8 * c + 1] * bfhi(w.x) + q[8 * c + 2] * bflo(w.y) + q[8 * c + 3] * bfhi(w.y) + q[8 * c + 4] * bflo(w.z) + q[8 * c + 5] * bfhi(w.z) + q[8 * c + 6] * bflo(w.w) + q[8 * c + 7] * bfhi(w.w); }
    return s;
}
__device__ __forceinline__ void pv_acc(const bf16_t* vp, float a, float p, float* O) {
#pragma unroll
    for (int c = 0; c < 8; ++c) { const uint4 w = ((const uint4*)vp)[c];
        O[8 * c] = O[8 * c] * a + p * bflo(w.x); O[8 * c + 1] = O[8 * c + 1] * a + p * bfhi(w.x); O[8 * c + 2] = O[8 * c + 2] * a + p * bflo(w.y); O[8 * c + 3] = O[8 * c + 3] * a + p * bfhi(w.y);
        O[8 * c + 4] = O[8 * c + 4] * a + p * bflo(w.z); O[8 * c + 5] = O[8 * c + 5] * a + p * bfhi(w.z); O[8 * c + 6] = O[8 * c + 6] * a + p * bflo(w.w); O[8 * c + 7] = O[8 * c + 7] * a + p * bfhi(w.w); }
}
__device__ __forceinline__ void osm_update(float sc, const bf16_t* vp, float& m, float& l, float* O) {
    const float mn = fmaxf(m, sc), a = __expf(m - mn), p = __expf(sc - mn);
    l = l * a + p; m = mn;
    pv_acc(vp, a, p, O);
}

__device__ __forceinline__ void attn_diff_unit(const Params& P, int l, int u, float lam, float lam_init) {
    const int lane = opaque_tid() & 63, st = lane >> 5;
    const int c = 255 - (u >> 3), bh = u & 7, b = bh >> 2, h = bh & 3;
    const int s = c * 32 + (lane & 31);
    const bf16_t* Q = (const bf16_t*)(P.ws + OFF_Q) + ((size_t)(b * NH + h) * SEQ) * 64 + st * 32;
    const bf16_t* K = (const bf16_t*)(P.ws + OFF_K) + ((size_t)(b * NH + h) * SEQ) * 64 + st * 32;
    const bf16_t* V = (const bf16_t*)(P.ws + OFF_V) + ((size_t)(b * NH + h) * SEQ) * 64;
    float q[32];
#pragma unroll
    for (int i = 0; i < 4; ++i) { const uint4 w = ((const uint4*)(Q + (size_t)s * 64))[i]; q[8 * i] = bflo(w.x); q[8 * i + 1] = bfhi(w.x); q[8 * i + 2] = bflo(w.y); q[8 * i + 3] = bfhi(w.y); q[8 * i + 4] = bflo(w.z); q[8 * i + 5] = bfhi(w.z); q[8 * i + 6] = bflo(w.w); q[8 * i + 7] = bfhi(w.w); }
    const float scale = 0.17677669529663687f;
#pragma unroll
    for (int i = 0; i < 32; ++i) q[i] *= scale;
    float O[64];
#pragma unroll
    for (int i = 0; i < 64; ++i) O[i] = 0.f;
    float m = -1e30f, lsum = 0.f;
    const int jmax = c * 32 + 31;
#pragma unroll 1
    for (int j = 0; j <= jmax; ++j) {
        const float sc = dotk<4>(K + (size_t)j * 64, q);
        if (j <= s) osm_update(sc, V + (size_t)j * 64, m, lsum, O);
    }
    const float inv = (st == 0) ? (1.0f / lsum) : (-lam / lsum);
    float ss = 0.f;
#pragma unroll
    for (int i = 0; i < 64; ++i) { float v = O[i] * inv; v += __shfl_xor(v, 32); O[i] = v; ss += v * v; }
    const float rstd = rsqrtf(ss * (1.0f / 64.0f) + EPS) * (1.0f - lam_init);
    const float* g = P.subln + l * 64;
#pragma unroll
    for (int i = 0; i < 64; ++i) O[i] = O[i] * rstd * g[i];
    if (st == 0) store_row64((bf16_t*)(P.ws + OFF_MIX) + (size_t)(b * SEQ + s) * 1024 + h * 64, O);
}

__device__ __forceinline__ void attn_dil_unit(const Params& P, int u) {
    const int lane = opaque_tid() & 63;
    const int c = u / 12, bh = u % 12, b = bh / 6, h = 4 + bh % 6;
    const int s = c * 64 + lane;
    const bf16_t* Q = (const bf16_t*)(P.ws + OFF_Q) + ((size_t)(b * NH + h) * SEQ) * 64;
    const bf16_t* K = (const bf16_t*)(P.ws + OFF_K) + ((size_t)(b * NH + h) * SEQ) * 64;
    const bf16_t* V = (const bf16_t*)(P.ws + OFF_V) + ((size_t)(b * NH + h) * SEQ) * 64;
    float q[64]; load_row64(Q + (size_t)s * 64, q);
#pragma unroll
    for (int i = 0; i < 64; ++i) q[i] *= 0.125f;
    float O[64];
#pragma unroll
    for (int i = 0; i < 64; ++i) O[i] = 0.f;
    float m = -1e30f, lsum = 0.f;
    for (int br = 0; br < 3; ++br) {
        const int d = br == 0 ? 1 : br == 1 ? 4 : 16;
#pragma unroll 1
        for (int t = 0; t <= 128; ++t) {
            const int kp = s - t * d;
            if (kp >= 0) {
                const float sc = dotk<8>(K + (size_t)kp * 64, q);
                osm_update(sc, V + (size_t)kp * 64, m, lsum, O);
            }
        }
    }
    const float inv = 1.0f / lsum;
#pragma unroll
    for (int i = 0; i < 64; ++i) O[i] *= inv;
    store_row64((bf16_t*)(P.ws + OFF_MIX) + (size_t)(b * SEQ + s) * 1024 + h * 64, O);
}

__device__ __forceinline__ void attn_moba_unit(const Params& P, int u) {
    const int lane = opaque_tid() & 63;
    const int c = 127 - u / 12, bh = u % 12, b = bh / 6, hm = bh % 6, h = 10 + hm;
    const int s = c * 64 + lane, own = c >> 2;
    const bf16_t* Q = (const bf16_t*)(P.ws + OFF_Q) + ((size_t)(b * NH + h) * SEQ) * 64;
    const bf16_t* K = (const bf16_t*)(P.ws + OFF_K) + ((size_t)(b * NH + h) * SEQ) * 64;
    const bf16_t* V = (const bf16_t*)(P.ws + OFF_V) + ((size_t)(b * NH + h) * SEQ) * 64;
    const float* KM = (const float*)(P.ws + OFF_KMEAN) + (size_t)((b * 6 + hm) * 32) * 64;
    float q[64]; load_row64(Q + (size_t)s * 64, q);
    float g0 = -INFINITY, g1 = -INFINITY, g2 = -INFINITY; int n0 = -1, n1 = -1, n2 = -1;
#pragma unroll 1
    for (int n = 0; n < own; ++n) {
        float g = 0.f;
#pragma unroll
        for (int i = 0; i < 64; ++i) g += q[i] * KM[n * 64 + i];
        if (g > g0) { g2 = g1; n2 = n1; g1 = g0; n1 = n0; g0 = g; n0 = n; }
        else if (g > g1) { g2 = g1; n2 = n1; g1 = g; n1 = n; }
        else if (g > g2) { g2 = g; n2 = n; }
    }
#pragma unroll
    for (int i = 0; i < 64; ++i) q[i] *= 0.125f;
    float O[64];
#pragma unroll
    for (int i = 0; i < 64; ++i) O[i] = 0.f;
    float m = -1e30f, lsum = 0.f;
    for (int n = 0; n <= own; ++n) {
        const bool selb = (n == own) || (n == n0) || (n == n1) || (n == n2);
        if (__ballot(selb) == 0ull) continue;
        const int jend = (n == own) ? (c * 64 + 63 - n * 256) : 255;
#pragma unroll 1
        for (int jj = 0; jj <= jend; ++jj) {
            const int j = n * 256 + jj;
            const float sc = dotk<8>(K + (size_t)j * 64, q);
            if (selb && j <= s) osm_update(sc, V + (size_t)j * 64, m, lsum, O);
        }
    }
    const float inv = 1.0f / lsum;
#pragma unroll
    for (int i = 0; i < 64; ++i) O[i] *= inv;
    store_row64((bf16_t*)(P.ws + OFF_MIX) + (size_t)(b * SEQ + s) * 1024 + h * 64, O);
}

typedef float f32x16 __attribute__((ext_vector_type(16)));
__device__ __forceinline__ int swap23(int r) { return (r & ~12) | ((r & 4) << 1) | ((r & 8) >> 1); }
constexpr int AT_ROWB = 144, AT_TILEB = 64 * AT_ROWB, AT_BUFB = 2 * AT_TILEB, AT_QWORD = 2 * AT_BUFB;
__device__ __forceinline__ bf16x8 pack8(const f32x16& x, int s) {
    bf16x8 p; unsigned* pu = (unsigned*)&p;
    pu[0] = pack2(x[8 * s], x[8 * s + 1]); pu[1] = pack2(x[8 * s + 2], x[8 * s + 3]); pu[2] = pack2(x[8 * s + 4], x[8 * s + 5]); pu[3] = pack2(x[8 * s + 6], x[8 * s + 7]);
    return p;
}
template <bool FIXED = false>
__device__ __forceinline__ void osm_tile(f32x16 (&x)[2], float sl2, float& m, float& l, f32x16 (&O)[2], bf16x8 (&pf)[2][2], bool en = true) {
    if (FIXED) {
        const float msubf = en ? m : INFINITY;
        float rsf[4] = {0.f, 0.f, 0.f, 0.f};
#pragma unroll
        for (int sub = 0; sub < 2; ++sub)
#pragma unroll
            for (int g = 0; g < 16; ++g) { const float e = fexp2(fmaf(x[sub][g], sl2, -msubf)); x[sub][g] = e; rsf[g & 3] += e; }
        l += (rsf[0] + rsf[1]) + (rsf[2] + rsf[3]);
#pragma unroll
        for (int sub = 0; sub < 2; ++sub) { pf[sub][0] = pack8(x[sub], 0); pf[sub][1] = pack8(x[sub], 1); }
        return;
    }
    float ma = fmaxf(x[0][0], fmaxf(x[0][1], x[0][2])), mb = fmaxf(x[0][8], fmaxf(x[0][9], x[0][10]));
    float mc = fmaxf(x[1][0], fmaxf(x[1][1], x[1][2])), md = fmaxf(x[1][8], fmaxf(x[1][9], x[1][10]));
#pragma unroll
    for (int g = 3; g < 7; g += 2) {
        ma = fmaxf(ma, fmaxf(x[0][g], x[0][g + 1])); mb = fmaxf(mb, fmaxf(x[0][g + 8], x[0][g + 9]));
        mc = fmaxf(mc, fmaxf(x[1][g], x[1][g + 1])); md = fmaxf(md, fmaxf(x[1][g + 8], x[1][g + 9]));
    }
    ma = fmaxf(ma, x[0][7]); mb = fmaxf(mb, x[0][15]); mc = fmaxf(mc, x[1][7]); md = fmaxf(md, x[1][15]);
    float mx = fmaxf(fmaxf(ma, mb), fmaxf(mc, md));
    mx = en ? mx : -INFINITY;
    mx = fmaxf(mx, __shfl_xor(mx, 32));
    const float mxs = mx * sl2;
    if (__ballot(mxs - m > 8.0f) != 0ull) {
        const float mn = fmaxf(m, mxs), alpha = fexp2(m - mn);
        m = mn; l *= alpha;
#pragma unroll
        for (int dt = 0; dt < 2; ++dt)
#pragma unroll
            for (int g = 0; g < 16; ++g) O[dt][g] *= alpha;
    }
    const float msub = en ? m : INFINITY;
    float rs[4] = {0.f, 0.f, 0.f, 0.f};
#pragma unroll
    for (int sub = 0; sub < 2; ++sub)
#pragma unroll
        for (int g = 0; g < 16; ++g) { const float e = fexp2(fmaf(x[sub][g], sl2, -msub)); x[sub][g] = e; rs[g & 3] += e; }
    l += (rs[0] + rs[1]) + (rs[2] + rs[3]);
#pragma unroll
    for (int sub = 0; sub < 2; ++sub) { pf[sub][0] = pack8(x[sub], 0); pf[sub][1] = pack8(x[sub], 1); }
}

__device__ __forceinline__ void osm_fix_sub(f32x16& x, float sl2, float m, float& l, bf16x8 (&pf)[2], bool en = true) {
    const float msub = en ? m : INFINITY;
    float rs[4] = {0.f, 0.f, 0.f, 0.f};
#pragma unroll
    for (int g = 0; g < 16; ++g) { const float e = fexp2(fmaf(x[g], sl2, -msub)); x[g] = e; rs[g & 3] += e; }
    l += (rs[0] + rs[1]) + (rs[2] + rs[3]);
    pf[0] = pack8(x, 0); pf[1] = pack8(x, 1);
}
__device__ __forceinline__ float compute_lam(const Params& P, int l, float lam_init) {
    const int lane = opaque_tid() & 63;
    float a1 = 0.f, a2 = 0.f;
    if (lane < 32) { a1 = P.lq1[l * 32 + lane] * P.lk1[l * 32 + lane]; a2 = P.lq2[l * 32 + lane] * P.lk2[l * 32 + lane]; }
#pragma unroll
    for (int o = 32; o > 0; o >>= 1) { a1 += __shfl_xor(a1, o); a2 += __shfl_xor(a2, o); }
    return expf(a1) - expf(a2) + lam_init;
}
template <int MODE> __device__ __forceinline__ void attn_mfma_unit(const Params& P, unsigned char* lds, int l, int b, int h, int qb) {
    const int tid = opaque_tid(), lane = tid & 63, wid = tid >> 6, r = lane & 31, hh = lane >> 5;
    const size_t bh = (size_t)(b * NH + h);
    const bf16_t* Qg = (const bf16_t*)(P.ws + OFF_Q) + bh * SEQ * 64;
    const bf16_t* Kg = (const bf16_t*)(P.ws + OFF_K) + bh * SEQ * 64;
    const bf16_t* VTg = (const bf16_t*)(P.ws + OFF_V) + (size_t)(b * NVSLOT + (MODE == 0 ? h : h - 6)) * SEQ * 64;
    const int q0 = qb * 256 + wid * 32, sq = q0 + r;
    bf16x8 qf[4];
#pragma unroll
    for (int ks = 0; ks < 4; ++ks) qf[ks] = *(const bf16x8*)(Qg + (size_t)sq * 64 + 16 * ks + 8 * hh);
    int n0 = -1, n1 = -1, n2 = -1;
    if (MODE == 1) {
        const int hm = h - 10, own = qb;
        const float* KM = (const float*)(P.ws + OFF_KMEAN) + (size_t)((b * 6 + hm) * 32) * 64;
        float qv[64]; load_row64(Qg + (size_t)sq * 64, qv);
        float g0 = -INFINITY, g1 = -INFINITY, g2 = -INFINITY;
#pragma unroll 1
        for (int n = 0; n < own; ++n) {
            float g = 0.f;
#pragma unroll
            for (int i = 0; i < 64; ++i) g += qv[i] * KM[n * 64 + i];
            if (g > g0) { g2 = g1; n2 = n1; g1 = g0; n1 = n0; g0 = g; n0 = n; }
            else if (g > g1) { g2 = g1; n2 = n1; g1 = g; n1 = n; }
            else if (g > g2) { g2 = g; n2 = n; }
        }
    }
    const float sl2 = (MODE == 0 ? 0.17677669529663687f : 0.125f) * 1.4426950408889634f;
    f32x16 O1[2], O2[2];
#pragma unroll
    for (int dt = 0; dt < 2; ++dt)
#pragma unroll
        for (int g = 0; g < 16; ++g) { O1[dt][g] = 0.f; O2[dt][g] = 0.f; }
    const float mfix = ((const float*)(P.ws + OFF_SB))[l * 4 + (MODE == 0 ? 0 : 1)];
    float m1 = mfix, l1 = 0.f, l2 = 0.f;
    const int lrow = tid >> 3, lch = tid & 7;
    const bf16_t* kload = Kg + (size_t)lrow * 64 + lch * 8;
    const bf16_t* vload = VTg + (size_t)lrow * SEQ + lch * 8;
    const int lwoff = lrow * AT_ROWB + lch * 16;
    const int ntile = 4 * (qb + 1);
    uint4 kr = *(const uint4*)kload, vr = *(const uint4*)vload;
    __syncthreads();
    *(uint4*)(lds + lwoff) = kr; *(uint4*)(lds + AT_TILEB + lwoff) = vr;
    __syncthreads();
    const int krow_off = swap23(r) * AT_ROWB + hh * 16, vrow_off = r * AT_ROWB + hh * 16;
#pragma unroll 1
    for (int t = 0; t < ntile; ++t) {
        const int k0 = t * 64;
        if (t + 1 < ntile) { kr = *(const uint4*)(kload + (size_t)(k0 + 64) * 64); vr = *(const uint4*)(vload + k0 + 64); }
        bool need = k0 <= q0 + 31;
        bool selb = true;
        if (MODE == 1) { const int n = t >> 2; selb = (n == qb) || (n == n0) || (n == n1) || (n == n2); need = need && (__ballot(selb) != 0ull); }
        if (need) {
            const unsigned char* kb = lds + (t & 1) * AT_BUFB; const unsigned char* vb = kb + AT_TILEB;
            f32x16 xa[2], xb[2];
            bf16x8 kfr[2][4];
#pragma unroll
            for (int sub = 0; sub < 2; ++sub)
#pragma unroll
                for (int ks = 0; ks < 4; ++ks) kfr[sub][ks] = *(const bf16x8*)(kb + sub * 32 * AT_ROWB + krow_off + ks * 32);
            __builtin_amdgcn_sched_barrier(0);
#pragma unroll
            for (int sub = 0; sub < 2; ++sub) {
#pragma unroll
                for (int g = 0; g < 16; ++g) { xa[sub][g] = 0.f; xb[sub][g] = 0.f; }
#pragma unroll
                for (int ks = 0; ks < 4; ++ks) {
                    if (MODE == 0 && ks >= 2) xb[sub] = __builtin_amdgcn_mfma_f32_32x32x16_bf16(kfr[sub][ks], qf[ks], xb[sub], 0, 0, 0);
                    else xa[sub] = __builtin_amdgcn_mfma_f32_32x32x16_bf16(kfr[sub][ks], qf[ks], xa[sub], 0, 0, 0);
                }
            }
            if (k0 + 63 > q0) {
#pragma unroll
                for (int sub = 0; sub < 2; ++sub)
#pragma unroll
                    for (int g = 0; g < 16; ++g) {
                        const int kp = k0 + sub * 32 + (g & 7) + 8 * hh + 16 * (g >> 3);
                        if (kp > sq) { xa[sub][g] = -INFINITY; if (MODE == 0) xb[sub][g] = -INFINITY; }
                    }
            }
            bf16x8 vfr[2][2][2];
#pragma unroll
            for (int dt = 0; dt < 2; ++dt)
#pragma unroll
                for (int sub = 0; sub < 2; ++sub)
#pragma unroll
                    for (int s = 0; s < 2; ++s) vfr[dt][sub][s] = *(const bf16x8*)(vb + dt * 32 * AT_ROWB + vrow_off + (sub * 32 + 16 * s) * 2);
            __builtin_amdgcn_sched_barrier(0);
#pragma unroll
            for (int sub = 0; sub < 2; ++sub) {
                bf16x8 pp[2];
                osm_fix_sub(xa[sub], sl2, m1, l1, pp, selb);
#pragma unroll
                for (int dt = 0; dt < 2; ++dt)
#pragma unroll
                    for (int s = 0; s < 2; ++s) O1[dt] = __builtin_amdgcn_mfma_f32_32x32x16_bf16(vfr[dt][sub][s], pp[s], O1[dt], 0, 0, 0);
                if (MODE == 0) {
                    bf16x8 pq[2];
                    osm_fix_sub(xb[sub], sl2, m1, l2, pq);
#pragma unroll
                    for (int dt = 0; dt < 2; ++dt)
#pragma unroll
                        for (int s = 0; s < 2; ++s) O2[dt] = __builtin_amdgcn_mfma_f32_32x32x16_bf16(vfr[dt][sub][s], pq[s], O2[dt], 0, 0, 0);
                }
            }
        }
        if (t + 1 < ntile) { unsigned char* wb = lds + ((t + 1) & 1) * AT_BUFB; *(uint4*)(wb + lwoff) = kr; *(uint4*)(wb + AT_TILEB + lwoff) = vr; }
        __syncthreads();
    }
    l1 += __shfl_xor(l1, 32);
    bf16_t* dst = (bf16_t*)(P.ws + OFF_MIX) + (size_t)(b * SEQ + sq) * 1024 + h * 64;
    if (MODE == 0) {
        l2 += __shfl_xor(l2, 32);
        int lq = l; asm volatile("" : "+s"(lq));
        const float lam_init = (lq == 0) ? 0.2f : 0.3555090675909693f;
        const float lam = compute_lam(P, l, lam_init);
        const float i1 = 1.0f / l1, i2 = lam / l2;
        float ss = 0.f;
#pragma unroll
        for (int dt = 0; dt < 2; ++dt)
#pragma unroll
            for (int g = 0; g < 16; ++g) { const float v = O1[dt][g] * i1 - O2[dt][g] * i2; O1[dt][g] = v; ss += v * v; }
        ss += __shfl_xor(ss, 32);
        const float rstd = rsqrtf(ss * (1.0f / 64.0f) + EPS) * (1.0f - lam_init);
        const float* gn = P.subln + l * 64;
#pragma unroll
        for (int dt = 0; dt < 2; ++dt)
#pragma unroll
            for (int gq = 0; gq < 4; ++gq) {
                const int d = 32 * dt + 8 * gq + 4 * hh;
                uint2 w; w.x = pack2(O1[dt][4 * gq] * rstd * gn[d], O1[dt][4 * gq + 1] * rstd * gn[d + 1]); w.y = pack2(O1[dt][4 * gq + 2] * rstd * gn[d + 2], O1[dt][4 * gq + 3] * rstd * gn[d + 3]);
                *(uint2*)(dst + d) = w;
            }
    } else {
        const float i1 = 1.0f / l1;
#pragma unroll
        for (int dt = 0; dt < 2; ++dt)
#pragma unroll
            for (int gq = 0; gq < 4; ++gq) {
                const int d = 32 * dt + 8 * gq + 4 * hh;
                uint2 w; w.x = pack2(O1[dt][4 * gq] * i1, O1[dt][4 * gq + 1] * i1); w.y = pack2(O1[dt][4 * gq + 2] * i1, O1[dt][4 * gq + 3] * i1);
                *(uint2*)(dst + d) = w;
            }
    }
}

__device__ __forceinline__ void wave_load(const bf16_t* kp, const bf16_t* vtp, size_t vts32, bf16x8 (&kf)[4], bf16x8 (&vf)[2][2]) {
#pragma unroll
    for (int ks = 0; ks < 4; ++ks) kf[ks] = *(const bf16x8*)(kp + 16 * ks);
#pragma unroll
    for (int dt = 0; dt < 2; ++dt)
#pragma unroll
        for (int s2 = 0; s2 < 2; ++s2) vf[dt][s2] = *(const bf16x8*)(vtp + dt * vts32 + 16 * s2);
}
template <class MaskFn>
__device__ __forceinline__ void wave_compute(const bf16x8 (&kf)[4], const bf16x8 (&vf)[2][2], const bf16x8 (&qf)[4], MaskFn mask, float sl2, float& m, float& l, f32x16 (&O)[2]) {
    f32x16 x;
#pragma unroll
    for (int g = 0; g < 16; ++g) x[g] = 0.f;
#pragma unroll
    for (int ks = 0; ks < 4; ++ks) x = __builtin_amdgcn_mfma_f32_32x32x16_bf16(kf[ks], qf[ks], x, 0, 0, 0);
#pragma unroll
    for (int g = 0; g < 16; ++g) if (!mask(g)) x[g] = -INFINITY;
    float mx = x[0];
#pragma unroll
    for (int g = 1; g < 16; ++g) mx = fmaxf(mx, x[g]);
    mx = fmaxf(mx, __shfl_xor(mx, 32));
    const float mn = fmaxf(m, mx * sl2), alpha = fexp2(m - mn);
    m = mn;
    float rs = 0.f;
#pragma unroll
    for (int g = 0; g < 16; ++g) { const float e = fexp2(fmaf(x[g], sl2, -mn)); x[g] = e; rs += e; }
    l = l * alpha + rs;
    if (__ballot(alpha != 1.0f) != 0ull) {
#pragma unroll
        for (int dt = 0; dt < 2; ++dt)
#pragma unroll
            for (int g = 0; g < 16; ++g) O[dt][g] *= alpha;
    }
    const bf16x8 p0 = pack8(x, 0), p1 = pack8(x, 1);
#pragma unroll
    for (int dt = 0; dt < 2; ++dt) {
        O[dt] = __builtin_amdgcn_mfma_f32_32x32x16_bf16(vf[dt][0], p0, O[dt], 0, 0, 0);
        O[dt] = __builtin_amdgcn_mfma_f32_32x32x16_bf16(vf[dt][1], p1, O[dt], 0, 0, 0);
    }
}
__device__ __forceinline__ void wave_store(bf16_t* dst, const f32x16 (&O)[2], float l, int hh) {
    l += __shfl_xor(l, 32);
    const float inv = 1.0f / l;
#pragma unroll
    for (int dt = 0; dt < 2; ++dt)
#pragma unroll
        for (int gq = 0; gq < 4; ++gq) {
            const int d = 32 * dt + 8 * gq + 4 * hh;
            uint2 w; w.x = pack2(O[dt][4 * gq] * inv, O[dt][4 * gq + 1] * inv); w.y = pack2(O[dt][4 * gq + 2] * inv, O[dt][4 * gq + 3] * inv);
            *(uint2*)(dst + d) = w;
        }
}
__device__ __forceinline__ void attn_dil_mfma(const Params& P, int u) {
    const int lane = opaque_tid() & 63, r = lane & 31, hh = lane >> 5;
    const int gi = u & 15, rho = (u >> 4) & 15, bhd = u >> 8, b = bhd / 6, hd = bhd % 6, h = 4 + hd;
    const size_t bh = (size_t)(b * NH + h);
    const bf16_t* Qg = (const bf16_t*)(P.ws + OFF_Q) + bh * SEQ * 64;
    const bf16_t* Kg = (const bf16_t*)(P.ws + OFF_K) + bh * SEQ * 64;
    const bf16_t* VT = (const bf16_t*)(P.ws + OFF_V) + (size_t)(b * NVSLOT + 10 + hd * 3) * 64 * SEQ;
    const int pos = rho + 16 * (32 * gi + r);
    bf16x8 qf[4];
#pragma unroll
    for (int ks = 0; ks < 4; ++ks) qf[ks] = *(const bf16x8*)(Qg + (size_t)pos * 64 + 16 * ks + 8 * hh);
    f32x16 O[2];
#pragma unroll
    for (int dt = 0; dt < 2; ++dt)
#pragma unroll
        for (int g = 0; g < 16; ++g) O[dt][g] = 0.f;
    float m = -1e30f, l = 0.f;
    const float sl2 = 0.125f * 1.4426950408889634f;
    const int kslot = swap23(r);
    const int t0a = gi == 0 ? 4 : 0, t0c = gi < 4 ? 4 - gi : 0;
    const int na = 20 - t0a, nb = 8 - t0a, ntl = na + nb + 5 - t0c;
    const int r4 = rho & 3;
    auto ptrs = [&](int j, const bf16_t*& kp, const bf16_t*& vtp, int& start, int& mq) {
        if (j < na) { start = 512 * gi - 128 + 32 * (j + t0a); mq = pos; kp = Kg + (size_t)(start + kslot) * 64 + 8 * hh; vtp = VT + (size_t)r * SEQ + start + 8 * hh; }
        else if (j < na + nb) { start = 128 * (gi - 1) + 32 * (j - na + t0a); mq = (rho >> 2) + 128 * gi + 4 * r; kp = Kg + (size_t)((start + kslot) * 4 + r4) * 64 + 8 * hh; vtp = VT + (size_t)64 * SEQ + r4 * 2048 + (size_t)r * SEQ + start + 8 * hh; }
        else { start = 32 * gi - 128 + 32 * (j - na - nb + t0c); mq = 32 * gi + r; kp = Kg + (size_t)((start + kslot) * 16 + rho) * 64 + 8 * hh; vtp = VT + (size_t)128 * SEQ + rho * 512 + (size_t)r * SEQ + start + 8 * hh; }
    };
    bf16x8 kfA[4], vfA[2][2], kfB[4], vfB[2][2];
    int startA, mqA, startB = 0, mqB = 0;
    { const bf16_t* kp; const bf16_t* vtp; ptrs(0, kp, vtp, startA, mqA); wave_load(kp, vtp, (size_t)32 * SEQ, kfA, vfA); }
#pragma unroll 1
    for (int j = 0; j < ntl; j += 2) {
        if (j + 1 < ntl) { const bf16_t* kp; const bf16_t* vtp; ptrs(j + 1, kp, vtp, startB, mqB); wave_load(kp, vtp, (size_t)32 * SEQ, kfB, vfB); }
        wave_compute(kfA, vfA, qf, [&](int g) { const int dl = mqA - (startA + (g & 7) + 8 * hh + 16 * (g >> 3)); return dl >= 0 && dl <= 128; }, sl2, m, l, O);
        if (j + 1 < ntl) {
            if (j + 2 < ntl) { const bf16_t* kp; const bf16_t* vtp; ptrs(j + 2, kp, vtp, startA, mqA); wave_load(kp, vtp, (size_t)32 * SEQ, kfA, vfA); }
            wave_compute(kfB, vfB, qf, [&](int g) { const int dl = mqB - (startB + (g & 7) + 8 * hh + 16 * (g >> 3)); return dl >= 0 && dl <= 128; }, sl2, m, l, O);
        }
    }
    wave_store((bf16_t*)(P.ws + OFF_MIX) + (size_t)(b * SEQ + pos) * 1024 + h * 64, O, l, hh);
}
__device__ __forceinline__ void xattn_mfma_phase(const Params& P) {
    const int tid_ = opaque_tid(), lane = tid_ & 63, r = lane & 31, hh = lane >> 5, gw = blockIdx.x * 8 + (tid_ >> 6);
    const bf16_t* QM = (const bf16_t*)(P.ws + OFF_QM); const bf16_t* KM = (const bf16_t*)(P.ws + OFF_KMEM); const bf16_t* VMT = (const bf16_t*)(P.ws + OFF_VMEM);
    bf16_t* OM = (bf16_t*)(P.ws + OFF_OM);
    const float sl2 = 0.125f * 1.4426950408889634f;
    const int kslot = swap23(r);
    for (int u = gw; u < NTOK / 32 * 4; u += gridDim.x * 8) {
        const int h = u & 3, tok = (u >> 2) * 32 + r, b = tok >> 13;
        bf16x8 qf[4];
#pragma unroll
        for (int ks = 0; ks < 4; ++ks) qf[ks] = *(const bf16x8*)(QM + (size_t)tok * 256 + h * 64 + 16 * ks + 8 * hh);
        f32x16 O[2];
#pragma unroll
        for (int dt = 0; dt < 2; ++dt)
#pragma unroll
            for (int g = 0; g < 16; ++g) O[dt][g] = 0.f;
        float m = -1e30f, l = 0.f;
        const bf16_t* kp0 = KM + (size_t)(b * MEM_LEN + kslot) * 256 + h * 64 + 8 * hh;
        const bf16_t* vtp0 = VMT + ((size_t)(b * 4 + h) * 64 + r) * 256 + 8 * hh;
        bf16x8 kfA[4], vfA[2][2], kfB[4], vfB[2][2];
        wave_load(kp0, vtp0, (size_t)32 * 256, kfA, vfA);
#pragma unroll 1
        for (int tt = 0; tt < 8; tt += 2) {
            wave_load(kp0 + (size_t)(32 * tt + 32) * 256, vtp0 + 32 * tt + 32, (size_t)32 * 256, kfB, vfB);
            wave_compute(kfA, vfA, qf, [](int) { return true; }, sl2, m, l, O);
            if (tt + 2 < 8) wave_load(kp0 + (size_t)(32 * tt + 64) * 256, vtp0 + 32 * tt + 64, (size_t)32 * 256, kfA, vfA);
            wave_compute(kfB, vfB, qf, [](int) { return true; }, sl2, m, l, O);
        }
        wave_store(OM + (size_t)tok * 256 + h * 64, O, l, hh);
    }
}

constexpr size_t PA_REC = 136, OFF_PA0 = OFF_XN, OFF_PA1 = OFF_XN + (size_t)16 * 1024 * 1024;
static_assert((size_t)BATCH * 6 * SEQ * PA_REC <= (size_t)16 * 1024 * 1024, "PA overlay");
template <int BR>
__device__ __forceinline__ void attn_dilwin_unit(const Params& P, unsigned char* lds, int l_, int b, int hd, int res, int qb) {
    constexpr int D = BR == 0 ? 1 : (BR == 1 ? 4 : 16);
    const int tid = opaque_tid(), lane = tid & 63, wid = tid >> 6, r = lane & 31, hh = lane >> 5;
    const int h = 4 + hd;
    const size_t bh = (size_t)(b * NH + h);
    const bf16_t* Qg = (const bf16_t*)(P.ws + OFF_Q) + bh * SEQ * 64;
    const bf16_t* Kg = (const bf16_t*)(P.ws + OFF_K) + bh * SEQ * 64;
    const bf16_t* VTs = (const bf16_t*)(P.ws + OFF_V) + (size_t)(b * NVSLOT + 10 + hd * 3 + BR) * 64 * SEQ + res * (SEQ / D);
    const int q0 = qb * 256 + wid * 32, qi = q0 + r, pos = qi * D + res;
    bf16x8 qf[4];
#pragma unroll
    for (int ks = 0; ks < 4; ++ks) qf[ks] = *(const bf16x8*)(Qg + (size_t)pos * 64 + 16 * ks + 8 * hh);
    const float sl2 = 0.125f * 1.4426950408889634f;
    f32x16 O[2];
#pragma unroll
    for (int dt = 0; dt < 2; ++dt)
#pragma unroll
        for (int g = 0; g < 16; ++g) O[dt][g] = 0.f;
    float m = ((const float*)(P.ws + OFF_SB))[l_ * 4 + 2], l = 0.f;
    const int lrow = tid >> 3, lch = tid & 7;
    const int lwoff = lrow * AT_ROWB + lch * 16;
    const int tlo = qb == 0 ? 0 : 4 * qb - 2, thi = 4 * qb + 3;
    const bf16_t* kload = Kg + ((size_t)lrow * D + res) * 64 + lch * 8;
    const bf16_t* vload = VTs + (size_t)lrow * SEQ + lch * 8;
    uint4 kr = *(const uint4*)(kload + (size_t)tlo * 64 * D * 64), vr = *(const uint4*)(vload + tlo * 64);
    __syncthreads();
    *(uint4*)(lds + (tlo & 1) * AT_BUFB + lwoff) = kr; *(uint4*)(lds + (tlo & 1) * AT_BUFB + AT_TILEB + lwoff) = vr;
    __syncthreads();
    const int krow_off = swap23(r) * AT_ROWB + hh * 16, vrow_off = r * AT_ROWB + hh * 16;
#pragma unroll 1
    for (int t = tlo; t <= thi; ++t) {
        const int k0 = t * 64;
        if (t < thi) { kr = *(const uint4*)(kload + (size_t)(t + 1) * 64 * D * 64); vr = *(const uint4*)(vload + (t + 1) * 64); }
        if (k0 <= q0 + 31 && k0 + 63 >= q0 - 128) {
            const unsigned char* kb = lds + (t & 1) * AT_BUFB; const unsigned char* vb = kb + AT_TILEB;
            f32x16 xa[2];
#pragma unroll
            for (int sub = 0; sub < 2; ++sub) {
#pragma unroll
                for (int g = 0; g < 16; ++g) xa[sub][g] = 0.f;
#pragma unroll
                for (int ks = 0; ks < 4; ++ks) {
                    const bf16x8 kf = *(const bf16x8*)(kb + sub * 32 * AT_ROWB + krow_off + ks * 32);
                    xa[sub] = __builtin_amdgcn_mfma_f32_32x32x16_bf16(kf, qf[ks], xa[sub], 0, 0, 0);
                }
            }
            if (k0 + 63 > q0 || k0 < q0 + 31 - 128) {
#pragma unroll
                for (int sub = 0; sub < 2; ++sub)
#pragma unroll
                    for (int g = 0; g < 16; ++g) {
                        const int dl = qi - (k0 + sub * 32 + (g & 7) + 8 * hh + 16 * (g >> 3));
                        if (dl < 0 || dl > 128) xa[sub][g] = -INFINITY;
                    }
            }
            bf16x8 pa[2][2];
            osm_tile<true>(xa, sl2, m, l, O, pa);
#pragma unroll
            for (int dt = 0; dt < 2; ++dt)
#pragma unroll
                for (int sub = 0; sub < 2; ++sub)
#pragma unroll
                    for (int s2 = 0; s2 < 2; ++s2) {
                        const bf16x8 vf = *(const bf16x8*)(vb + dt * 32 * AT_ROWB + vrow_off + (sub * 32 + 16 * s2) * 2);
                        O[dt] = __builtin_amdgcn_mfma_f32_32x32x16_bf16(vf, pa[sub][s2], O[dt], 0, 0, 0);
                    }
        }
        if (t < thi) { unsigned char* wb = lds + ((t + 1) & 1) * AT_BUFB; *(uint4*)(wb + lwoff) = kr; *(uint4*)(wb + AT_TILEB + lwoff) = vr; }
        __syncthreads();
    }
    l += __shfl_xor(l, 32);
    const size_t rec = ((size_t)(b * 6 + hd) * SEQ + pos) * PA_REC;
    if (BR < 2) {
        unsigned char* pa = P.ws + (BR == 0 ? OFF_PA0 : OFF_PA1) + rec;
#pragma unroll
        for (int dt = 0; dt < 2; ++dt)
#pragma unroll
            for (int gq = 0; gq < 4; ++gq) {
                const int d = 32 * dt + 8 * gq + 4 * hh;
                uint2 w; w.x = pack2(O[dt][4 * gq], O[dt][4 * gq + 1]); w.y = pack2(O[dt][4 * gq + 2], O[dt][4 * gq + 3]);
                *(uint2*)(pa + 2 * d) = w;
            }
        if (hh == 0) { float2 ml; ml.x = m; ml.y = l; *(float2*)(pa + 128) = ml; }
    } else {
        const unsigned char* p0 = P.ws + OFF_PA0 + rec; const unsigned char* p1 = P.ws + OFF_PA1 + rec;
        const float2 ml0 = *(const float2*)(p0 + 128), ml1 = *(const float2*)(p1 + 128);
        const float mm = fmaxf(m, fmaxf(ml0.x, ml1.x));
        const float f0 = fexp2(ml0.x - mm), f1 = fexp2(ml1.x - mm), f2 = fexp2(m - mm);
        const float inv = 1.0f / (ml0.y * f0 + ml1.y * f1 + l * f2);
        bf16_t* dst = (bf16_t*)(P.ws + OFF_MIX) + (size_t)(b * SEQ + pos) * 1024 + h * 64;
#pragma unroll
        for (int dt = 0; dt < 2; ++dt)
#pragma unroll
            for (int gq = 0; gq < 4; ++gq) {
                const int d = 32 * dt + 8 * gq + 4 * hh;
                const uint2 a0 = *(const uint2*)(p0 + 2 * d), a1 = *(const uint2*)(p1 + 2 * d);
                const float o0 = (bflo(a0.x) * f0 + bflo(a1.x) * f1 + O[dt][4 * gq] * f2) * inv, o1 = (bfhi(a0.x) * f0 + bfhi(a1.x) * f1 + O[dt][4 * gq + 1] * f2) * inv;
                const float o2 = (bflo(a0.y) * f0 + bflo(a1.y) * f1 + O[dt][4 * gq + 2] * f2) * inv, o3 = (bfhi(a0.y) * f0 + bfhi(a1.y) * f1 + O[dt][4 * gq + 3] * f2) * inv;
                uint2 w; w.x = pack2(o0, o1); w.y = pack2(o2, o3);
                *(uint2*)(dst + d) = w;
            }
    }
}
__device__ __forceinline__ void dil01_phase(const Params& P, unsigned char* lds, int l_) {
    for (int u = blockIdx.x; u < 768; u += gridDim.x) {
        const int br = u / 384, v = u % 384, bhd = v >> 5, u32 = v & 31, b = bhd / 6, hd = bhd % 6;
        if (br == 0) attn_dilwin_unit<0>(P, lds, l_, b, hd, 0, u32);
        else attn_dilwin_unit<1>(P, lds, l_, b, hd, u32 >> 3, u32 & 7);
    }
}

__device__ __forceinline__ void xattn_block_phase(const Params& P, unsigned char* lds, int l_) {
    const int tid = opaque_tid(), lane = tid & 63, wid = tid >> 6, r = lane & 31, hh = lane >> 5;
    const bf16_t* QM = (const bf16_t*)(P.ws + OFF_QM); const bf16_t* KM = (const bf16_t*)(P.ws + OFF_KMEM); const bf16_t* VMT = (const bf16_t*)(P.ws + OFF_VMEM);
    bf16_t* OM = (bf16_t*)(P.ws + OFF_OM);
    const float sl2 = 0.125f * 1.4426950408889634f;
    const int lrow = tid >> 3, lch = tid & 7, lwoff = lrow * AT_ROWB + lch * 16;
    const int krow_off = swap23(r) * AT_ROWB + hh * 16, vrow_off = r * AT_ROWB + hh * 16;
    for (int u = blockIdx.x; u < (NTOK / 256) * 4; u += gridDim.x) {
        const int h = u & 3, tok = (u >> 2) * 256 + wid * 32 + r, b = (u >> 2) >> 5;
        bf16x8 qf[4];
#pragma unroll
        for (int ks = 0; ks < 4; ++ks) qf[ks] = *(const bf16x8*)(QM + (size_t)tok * 256 + h * 64 + 16 * ks + 8 * hh);
        f32x16 O[2];
#pragma unroll
        for (int dt = 0; dt < 2; ++dt)
#pragma unroll
            for (int g = 0; g < 16; ++g) O[dt][g] = 0.f;
        float m = ((const float*)(P.ws + OFF_SB))[l_ * 4 + 3], l = 0.f;
        const bf16_t* kload = KM + (size_t)(b * MEM_LEN + lrow) * 256 + h * 64 + lch * 8;
        const bf16_t* vload = VMT + ((size_t)(b * 4 + h) * 64 + lrow) * 256 + lch * 8;
        uint4 kr = *(const uint4*)kload, vr = *(const uint4*)vload;
        __syncthreads();
        *(uint4*)(lds + lwoff) = kr; *(uint4*)(lds + AT_TILEB + lwoff) = vr;
        __syncthreads();
#pragma unroll 1
        for (int t = 0; t < 4; ++t) {
            if (t < 3) { kr = *(const uint4*)(kload + (size_t)(t + 1) * 64 * 256); vr = *(const uint4*)(vload + (t + 1) * 64); }
            const unsigned char* kb = lds + (t & 1) * AT_BUFB; const unsigned char* vb = kb + AT_TILEB;
            f32x16 xa[2];
#pragma unroll
            for (int sub = 0; sub < 2; ++sub) {
#pragma unroll
                for (int g = 0; g < 16; ++g) xa[sub][g] = 0.f;
#pragma unroll
                for (int ks = 0; ks < 4; ++ks) {
                    const bf16x8 kf = *(const bf16x8*)(kb + sub * 32 * AT_ROWB + krow_off + ks * 32);
                    xa[sub] = __builtin_amdgcn_mfma_f32_32x32x16_bf16(kf, qf[ks], xa[sub], 0, 0, 0);
                }
            }
            bf16x8 pa[2][2];
            osm_tile<true>(xa, sl2, m, l, O, pa);
#pragma unroll
            for (int dt = 0; dt < 2; ++dt)
#pragma unroll
                for (int sub = 0; sub < 2; ++sub)
#pragma unroll
                    for (int s2 = 0; s2 < 2; ++s2) {
                        const bf16x8 vf = *(const bf16x8*)(vb + dt * 32 * AT_ROWB + vrow_off + (sub * 32 + 16 * s2) * 2);
                        O[dt] = __builtin_amdgcn_mfma_f32_32x32x16_bf16(vf, pa[sub][s2], O[dt], 0, 0, 0);
                    }
            if (t < 3) { unsigned char* wb = lds + ((t + 1) & 1) * AT_BUFB; *(uint4*)(wb + lwoff) = kr; *(uint4*)(wb + AT_TILEB + lwoff) = vr; }
            __syncthreads();
        }
        wave_store(OM + (size_t)tok * 256 + h * 64, O, l, hh);
    }
}

__device__ __forceinline__ void kmean_phase(const Params& P, unsigned char* lds) {
    const int tid = opaque_tid(), cg8 = tid & 7, rg = tid >> 3;
    float* red = (float*)lds;
    for (int u = blockIdx.x; u < 2 * 6 * 32; u += gridDim.x) {
        const int n = u & 31, bh = u >> 5, b = bh / 6, hm = bh % 6;
        const bf16_t* K = (const bf16_t*)(P.ws + OFF_K) + ((size_t)(b * NH + 10 + hm) * SEQ + n * 256) * 64;
        float acc[8];
#pragma unroll
        for (int i = 0; i < 8; ++i) acc[i] = 0.f;
#pragma unroll
        for (int p = 0; p < 4; ++p) {
            const uint4 w = *(const uint4*)(K + (size_t)(rg + 64 * p) * 64 + cg8 * 8);
            acc[0] += bflo(w.x); acc[1] += bfhi(w.x); acc[2] += bflo(w.y); acc[3] += bfhi(w.y); acc[4] += bflo(w.z); acc[5] += bfhi(w.z); acc[6] += bflo(w.w); acc[7] += bfhi(w.w);
        }
        __syncthreads();
#pragma unroll
        for (int i = 0; i < 8; ++i) red[rg * 64 + cg8 * 8 + i] = acc[i];
        __syncthreads();
        if (tid < 64) {
            float sum = 0.f;
            for (int g = 0; g < 64; ++g) sum += red[g * 64 + tid];
            ((float*)(P.ws + OFF_KMEAN))[(size_t)u * 64 + tid] = sum * (1.0f / 256.0f);
        }
    }
}

__device__ __forceinline__ void xattn_phase(const Params& P) {
    const int tid_ = opaque_tid(), lane = tid_ & 63, gw = blockIdx.x * 8 + (tid_ >> 6);
    const bf16_t* QM = (const bf16_t*)(P.ws + OFF_QM); const bf16_t* KM = (const bf16_t*)(P.ws + OFF_KMEM); const bf16_t* VM = (const bf16_t*)(P.ws + OFF_VMEM);
    bf16_t* OM = (bf16_t*)(P.ws + OFF_OM);
    for (int u = gw; u < NTOK * 4 / 64; u += gridDim.x * 8) {
        const int h = u & 3, tok = (u >> 2) * 64 + lane, b = tok >> 13;
        float q[64]; load_row64(QM + (size_t)tok * 256 + h * 64, q);
#pragma unroll
        for (int i = 0; i < 64; ++i) q[i] *= 0.125f;
        float O[64];
#pragma unroll
        for (int i = 0; i < 64; ++i) O[i] = 0.f;
        float m = -1e30f, lsum = 0.f;
#pragma unroll 1
        for (int j = 0; j < MEM_LEN; ++j) {
            const float sc = dotk<8>(KM + (size_t)(b * MEM_LEN + j) * 256 + h * 64, q);
            osm_update(sc, VM + (size_t)(b * MEM_LEN + j) * 256 + h * 64, m, lsum, O);
        }
        const float inv = 1.0f / lsum;
#pragma unroll
        for (int i = 0; i < 64; ++i) O[i] *= inv;
        store_row64(OM + (size_t)tok * 256 + h * 64, O);
    }
}

__device__ const unsigned short kUnitOrder[1024] = {992, 993, 994, 995, 996, 997, 998, 999, 960, 961, 962, 963, 964, 965, 966, 967, 928, 929, 930, 931, 932, 933, 934, 935, 896, 897, 898, 899, 900, 901, 902, 903, 864, 865, 866, 867, 868, 869, 870, 871, 832, 833, 834, 835, 836, 837, 838, 839, 800, 801, 802, 803, 804, 805, 806, 807, 768, 769, 770, 771, 772, 773, 774, 775, 736, 737, 738, 739, 740, 741, 742, 743, 704, 705, 706, 707, 708, 709, 710, 711, 672, 673, 674, 675, 676, 677, 678, 679, 640, 641, 642, 643, 644, 645, 646, 647, 608, 609, 610, 611, 612, 613, 614, 615, 576, 577, 578, 579, 580, 581, 582, 583, 1008, 1009, 1010, 1011, 1012, 1013, 1014, 1015, 1016, 1017, 1018, 1019, 544, 545, 546, 547, 548, 549, 550, 551, 976, 977, 978, 979, 980, 981, 982, 983, 984, 985, 986, 987, 944, 945, 946, 947, 948, 949, 950, 951, 952, 953, 954, 955, 512, 513, 514, 515, 516, 517, 518, 519, 912, 913, 914, 915, 916, 917, 918, 919, 920, 921, 922, 923, 480, 481, 482, 483, 484, 485, 486, 487, 880, 881, 882, 883, 884, 885, 886, 887, 888, 889, 890, 891, 848, 849, 850, 851, 852, 853, 854, 855, 856, 857, 858, 859, 448, 449, 450, 451, 452, 453, 454, 455, 816, 817, 818, 819, 820, 821, 822, 823, 824, 825, 826, 827, 784, 785, 786, 787, 788, 789, 790, 791, 792, 793, 794, 795, 416, 417, 418, 419, 420, 421, 422, 423, 752, 753, 754, 755, 756, 757, 758, 759, 760, 761, 762, 763, 720, 721, 722, 723, 724, 725, 726, 727, 728, 729, 730, 731, 384, 385, 386, 387, 388, 389, 390, 391, 688, 689, 690, 691, 692, 693, 694, 695, 696, 697, 698, 699, 352, 353, 354, 355, 356, 357, 358, 359, 656, 657, 658, 659, 660, 661, 662, 663, 664, 665, 666, 667, 624, 625, 626, 627, 628, 629, 630, 631, 632, 633, 634, 635, 320, 321, 322, 323, 324, 325, 326, 327, 592, 593, 594, 595, 596, 597, 598, 599, 600, 601, 602, 603, 560, 561, 562, 563, 564, 565, 566, 567, 568, 569, 570, 571, 288, 289, 290, 291, 292, 293, 294, 295, 528, 529, 530, 531, 532, 533, 534, 535, 536, 537, 538, 539, 496, 497, 498, 499, 500, 501, 502, 503, 504, 505, 506, 507, 256, 257, 258, 259, 260, 261, 262, 263, 464, 465, 466, 467, 468, 469, 470, 471, 472, 473, 474, 475, 224, 225, 226, 227, 228, 229, 230, 231, 432, 433, 434, 435, 436, 437, 438, 439, 440, 441, 442, 443, 400, 401, 402, 403, 404, 405, 406, 407, 408, 409, 410, 411, 192, 193, 194, 195, 196, 197, 198, 199, 368, 369, 370, 371, 372, 373, 374, 375, 376, 377, 378, 379, 336, 337, 338, 339, 340, 341, 342, 343, 344, 345, 346, 347, 160, 161, 162, 163, 164, 165, 166, 167, 304, 305, 306, 307, 308, 309, 310, 311, 312, 313, 314, 315, 272, 273, 274, 275, 276, 277, 278, 279, 280, 281, 282, 283, 128, 129, 130, 131, 132, 133, 134, 135, 240, 241, 242, 243, 244, 245, 246, 247, 248, 249, 250, 251, 96, 97, 98, 99, 100, 101, 102, 103, 208, 209, 210, 211, 212, 213, 214, 215, 216, 217, 218, 219, 176, 177, 178, 179, 180, 181, 182, 183, 184, 185, 186, 187, 64, 65, 66, 67, 68, 69, 70, 71, 144, 145, 146, 147, 148, 149, 150, 151, 152, 153, 154, 155, 112, 113, 114, 115, 116, 117, 118, 119, 120, 121, 122, 123, 32, 33, 34, 35, 36, 37, 38, 39, 80, 81, 82, 83, 84, 85, 86, 87, 88, 89, 90, 91, 48, 49, 50, 51, 52, 53, 54, 55, 56, 57, 58, 59, 0, 1, 2, 3, 4, 5, 6, 7, 32768, 32769, 32770, 32771, 32772, 32773, 32774, 32775, 32776, 32777, 32778, 32779, 32780, 32781, 32782, 32783, 32784, 32785, 32786, 32787, 32788, 32789, 32790, 32791, 32792, 32793, 32794, 32795, 32796, 32797, 32798, 32799, 32800, 32801, 32802, 32803, 32804, 32805, 32806, 32807, 32808, 32809, 32810, 32811, 32812, 32813, 32814, 32815, 32816, 32817, 32818, 32819, 32820, 32821, 32822, 32823, 32824, 32825, 32826, 32827, 32828, 32829, 32830, 32831, 32832, 32833, 32834, 32835, 32836, 32837, 32838, 32839, 32840, 32841, 32842, 32843, 32844, 32845, 32846, 32847, 32848, 32849, 32850, 32851, 32852, 32853, 32854, 32855, 32856, 32857, 32858, 32859, 32860, 32861, 32862, 32863, 32864, 32865, 32866, 32867, 32868, 32869, 32870, 32871, 32872, 32873, 32874, 32875, 32876, 32877, 32878, 32879, 32880, 32881, 32882, 32883, 32884, 32885, 32886, 32887, 32888, 32889, 32890, 32891, 32892, 32893, 32894, 32895, 32896, 32897, 32898, 32899, 32900, 32901, 32902, 32903, 32904, 32905, 32906, 32907, 32908, 32909, 32910, 32911, 32912, 32913, 32914, 32915, 32916, 32917, 32918, 32919, 32920, 32921, 32922, 32923, 32924, 32925, 32926, 32927, 32928, 32929, 32930, 32931, 32932, 32933, 32934, 32935, 32936, 32937, 32938, 32939, 32940, 32941, 32942, 32943, 32944, 32945, 32946, 32947, 32948, 32949, 32950, 32951, 32952, 32953, 32954, 32955, 32956, 32957, 32958, 32959, 32960, 32961, 32962, 32963, 32964, 32965, 32966, 32967, 32968, 32969, 32970, 32971, 32972, 32973, 32974, 32975, 32976, 32977, 32978, 32979, 32980, 32981, 32982, 32983, 32984, 32985, 32986, 32987, 32988, 32989, 32990, 32991, 32992, 32993, 32994, 32995, 32996, 32997, 32998, 32999, 33000, 33001, 33002, 33003, 33004, 33005, 33006, 33007, 33008, 33009, 33010, 33011, 33012, 33013, 33014, 33015, 33016, 33017, 33018, 33019, 33020, 33021, 33022, 33023, 33024, 33025, 33026, 33027, 33028, 33029, 33030, 33031, 33032, 33033, 33034, 33035, 33036, 33037, 33038, 33039, 33040, 33041, 33042, 33043, 33044, 33045, 33046, 33047, 33048, 33049, 33050, 33051, 33052, 33053, 33054, 33055, 33056, 33057, 33058, 33059, 33060, 33061, 33062, 33063, 33064, 33065, 33066, 33067, 33068, 33069, 33070, 33071, 33072, 33073, 33074, 33075, 33076, 33077, 33078, 33079, 33080, 33081, 33082, 33083, 33084, 33085, 33086, 33087, 33088, 33089, 33090, 33091, 33092, 33093, 33094, 33095, 33096, 33097, 33098, 33099, 33100, 33101, 33102, 33103, 33104, 33105, 33106, 33107, 33108, 33109, 33110, 33111, 33112, 33113, 33114, 33115, 33116, 33117, 33118, 33119, 33120, 33121, 33122, 33123, 33124, 33125, 33126, 33127, 33128, 33129, 33130, 33131, 33132, 33133, 33134, 33135, 33136, 33137, 33138, 33139, 33140, 33141, 33142, 33143, 33144, 33145, 33146, 33147, 33148, 33149, 33150, 33151, 16, 17, 18, 19, 20, 21, 22, 23, 24, 25, 26, 27};
__device__ __forceinline__ void attn_phase(const Params& P, unsigned char* lds, int l, unsigned* ctr) {
    const int tid = opaque_tid();
    constexpr int NUNITS = 1024;
    for (;;) {
        __syncthreads();
        if (tid == 0) *(int*)(lds + AT_QWORD) = (int)atomicAdd(ctr, 1u);
        __syncthreads();
        const int u = *(const int*)(lds + AT_QWORD);
        if (u >= NUNITS) break;
        const int code = kUnitOrder[u];
        if (code & 0x8000) { const int v = code & 0x7fff, bhd = v >> 5, u32 = v & 31; attn_dilwin_unit<2>(P, lds, l, bhd / 6, bhd % 6, u32 >> 1, u32 & 1); }
        else {
            const int qb = code >> 5, j = code & 15;
            if ((code & 16) == 0) attn_mfma_unit<0>(P, lds, l, j >> 2, j & 3, qb);
            else attn_mfma_unit<1>(P, lds, l, j / 6, 10 + j % 6, qb);
        }
    }
}


#define XB_TMO      128
#define XB_XCNT(j)  (256  + 64 * (j))
#define XB_XSUB(j)  (1280 + 64 * (j))
#define XB_XGEN(j)  (2304 + 64 * (j))
#define XB_TOP      3328
#define XB_TOPGEN   3392
#define XCD_BAR_WORDS 3456
#define XB_SPIN_CAP (1u << 18)
#define LAS __attribute__((address_space(3)))

__device__ __forceinline__ unsigned xb_ld(unsigned* p)              { return __hip_atomic_load(p, __ATOMIC_RELAXED, __HIP_MEMORY_SCOPE_AGENT); }
__device__ __forceinline__ unsigned xb_add(unsigned* p, unsigned v) { return __hip_atomic_fetch_add(p, v, __ATOMIC_RELAXED, __HIP_MEMORY_SCOPE_AGENT); }
__device__ __forceinline__ unsigned xb_xcc_id() { return (unsigned)__builtin_amdgcn_s_getreg((3 << 11) | 20) & 0xFu; }
#define XB_SPIN(cond, bar) do { unsigned _sp = 0; while (cond) { __builtin_amdgcn_s_sleep(1); \
    if ((++_sp & 255u) == 0u) { if (xb_ld(&(bar)[XB_TMO])) break; if (_sp > XB_SPIN_CAP) { atomicAdd(&(bar)[XB_TMO], 1u); break; } } } } while (0)

struct XcdBarrier {
    unsigned* bar; unsigned x;
    volatile LAS unsigned* st;
};

__device__ __forceinline__ XcdBarrier xcd_barrier_post(unsigned* bar, volatile LAS unsigned* st) {
    XcdBarrier b; b.bar = bar; b.x = xb_xcc_id(); b.st = st;
    if (threadIdx.x == 0) (void)xb_add(&bar[XB_XCNT(b.x)], 1u);
    return b;
}
__device__ __forceinline__ void xcd_barrier_complete(unsigned* bar, unsigned x, unsigned& nloc, unsigned& nx) {
    const unsigned G = gridDim.x * gridDim.y * gridDim.z;
    unsigned sum, cnt, mine, sp = 0u;
    for (;;) {
        sum = 0u; cnt = 0u; mine = 0u;
#pragma unroll
        for (unsigned j = 0; j < 16; ++j) { const unsigned c = xb_ld(&bar[XB_XCNT(j)]); sum += c; cnt += (c > 0u) ? 1u : 0u; mine = (j == x) ? c : mine; }
        if (sum == G) break;
        __builtin_amdgcn_s_sleep(1);
        if ((++sp & 255u) == 0u) { if (xb_ld(&bar[XB_TMO])) break; if (sp > XB_SPIN_CAP) { atomicAdd(&bar[XB_TMO], 1u); break; } }
    }
    nloc = mine > 0u ? mine : 1u; nx = cnt > 0u ? cnt : 1u;
}

__device__ __forceinline__ void xcd_barrier(const XcdBarrier& b) {
    asm volatile("s_waitcnt vmcnt(0)" ::: "memory");
    __syncthreads();
    if (threadIdx.x == 0) {
        unsigned* bar = b.bar;
        __builtin_amdgcn_s_waitcnt(0);
        unsigned nloc = b.st[0], nx = b.st[1];
        if (nloc == 0u) { xcd_barrier_complete(bar, b.x, nloc, nx); b.st[0] = nloc; b.st[1] = nx; }
        const unsigned old = xb_add(&bar[XB_XSUB(b.x)], 1u);
        const unsigned gen = old / nloc;
        if (old + 1u == (gen + 1u) * nloc) {
            __builtin_amdgcn_fence(__ATOMIC_RELEASE, "agent");
            asm volatile("s_waitcnt vmcnt(0)" ::: "memory");
            const unsigned og = xb_add(&bar[XB_TOP], 1u);
            const unsigned tg = og / nx;
            if (og + 1u == (tg + 1u) * nx) xb_add(&bar[XB_TOPGEN], 1u);
            else XB_SPIN(xb_ld(&bar[XB_TOPGEN]) == tg, bar);
            __builtin_amdgcn_fence(__ATOMIC_ACQUIRE, "agent");
            xb_add(&bar[XB_XGEN(b.x)], 1u);
            asm volatile("s_waitcnt vmcnt(0)" ::: "memory");
        } else {
            XB_SPIN(xb_ld(&bar[XB_XGEN(b.x)]) == gen, bar);
            __builtin_amdgcn_fence(__ATOMIC_ACQUIRE, "agent");
            asm volatile("s_waitcnt vmcnt(0)" ::: "memory");
        }
    }
    __syncthreads();
}

__device__ __forceinline__ void xcd_barrier_at(unsigned char* ws, volatile LAS unsigned* st) {
    XcdBarrier c; c.bar = (unsigned*)(ws + OFF_BAR); c.st = st; c.x = (unsigned)__builtin_amdgcn_readfirstlane((int)st[2]);
    xcd_barrier(c);
}
__device__ __forceinline__ int wmap(int map, int j) {
    if (map == 1) { const int c = j & 255; return (j & ~255) + 64 * ((c >> 5) & 3) + 32 * (c >> 7) + (c & 31); }
    if (map == 2) { const int t = j >> 8, c = j & 255; return c < 128 ? 128 * t + c : D_FF + 128 * t + (c - 128); }
    return j;
}
__device__ __forceinline__ void convert_weight(unsigned char* lds, const float* __restrict__ src, int ldw, int K, int N, bf16_t* __restrict__ dst, int map, int col0, int rot, const float* __restrict__ gk) {
    const int tid = opaque_tid();
    bf16_t* tile = (bf16_t*)lds;
    const int tk = K / 128, ntiles = (N / 64) * tk;
    const int kk = tid >> 4, n4 = (tid & 15) * 4, jr = tid >> 4, k8 = (tid & 15) * 8;
    int t = (int)((blockIdx.x + gridDim.x - (unsigned)rot % gridDim.x) % gridDim.x);
    float4 v[4];
    if (t < ntiles) {
        const int j0 = (t / tk) * 64, k0 = (t % tk) * 128, sc = col0 + wmap(map, j0 + (n4 & 32)) + (n4 & 31);
#pragma unroll
        for (int p = 0; p < 4; ++p) v[p] = *(const float4*)(src + (size_t)(k0 + p * 32 + kk) * ldw + sc);
    }
    for (; t < ntiles; t += gridDim.x) {
        const int j0 = (t / tk) * 64, k0 = (t % tk) * 128;
        __syncthreads();
#pragma unroll
        for (int p = 0; p < 4; ++p) {
            const float g = gk ? gk[k0 + p * 32 + kk] : 1.0f;
            tile[(n4 + 0) * 136 + p * 32 + kk] = f2bf(v[p].x * g); tile[(n4 + 1) * 136 + p * 32 + kk] = f2bf(v[p].y * g); tile[(n4 + 2) * 136 + p * 32 + kk] = f2bf(v[p].z * g); tile[(n4 + 3) * 136 + p * 32 + kk] = f2bf(v[p].w * g);
        }
        const int tn = t + gridDim.x;
        if (tn < ntiles) {
            const int j0n = (tn / tk) * 64, k0n = (tn % tk) * 128, sc = col0 + wmap(map, j0n + (n4 & 32)) + (n4 & 31);
#pragma unroll
            for (int p = 0; p < 4; ++p) v[p] = *(const float4*)(src + (size_t)(k0n + p * 32 + kk) * ldw + sc);
        }
        __syncthreads();
#pragma unroll
        for (int q = 0; q < 2; ++q) *(uint4*)(dst + (size_t)(j0 + jr + 32 * q) * K + k0 + k8) = *(const uint4*)(tile + (jr + 32 * q) * 136 + k8);
    }
}
__device__ __forceinline__ void xb_rows(const float* __restrict__ X, bf16_t* __restrict__ xb, float* __restrict__ part, int nrows) {
    const int tid_ = opaque_tid(), lane = tid_ & 63, wid = tid_ >> 6;
    for (int row = blockIdx.x * 8 + wid; row < nrows; row += gridDim.x * 8) {
        const float4* xp = (const float4*)(X + (size_t)row * 1024);
        float ss = 0.f;
#pragma unroll
        for (int i = 0; i < 4; ++i) {
            const float4 v = xp[lane + 64 * i]; ss += v.x * v.x + v.y * v.y + v.z * v.z + v.w * v.w;
            uint2 w; w.x = pack2(v.x, v.y); w.y = pack2(v.z, v.w);
            *(uint2*)(xb + (size_t)row * 1024 + (lane + 64 * i) * 4) = w;
        }
#pragma unroll
        for (int o = 32; o > 0; o >>= 1) ss += __shfl_xor(ss, o);
        if (lane < 16) part[(size_t)row * 16 + lane] = lane == 0 ? ss : 0.f;
    }
}
__device__ __forceinline__ void prologue_phase(const Params& P, unsigned char* lds) {
    int rot = 0;
    for (int l = 0; l < DEPTH; ++l) {
        bf16_t* wb = (bf16_t*)(P.ws + OFF_WB) + (size_t)l * WB_LAYER;
        convert_weight(lds, P.w_in + (size_t)l * 1024 * 3072, 3072, 1024, 2048, wb + WB_IN, 1, 0, rot, P.norm_mix + l * 1024); rot += 256;
        convert_weight(lds, P.w_in + (size_t)l * 1024 * 3072, 3072, 1024, 1024, wb + WB_IN + (size_t)2048 * 1024, 0, 2048, rot, P.norm_mix + l * 1024); rot += 128;
        convert_weight(lds, P.w_out + (size_t)l * 1024 * 1024, 1024, 1024, 1024, wb + WB_OUT, 0, 0, rot, nullptr); rot += 128;
        convert_weight(lds, P.w_mq + (size_t)l * 1024 * 256, 256, 1024, 256, wb + WB_MQ, 1, 0, rot, P.norm_cross + l * 1024); rot += 32;
        convert_weight(lds, P.w_mkv + (size_t)l * 1024 * 512, 512, 1024, 512, wb + WB_MKV, 1, 0, rot, nullptr); rot += 64;
        convert_weight(lds, P.w_mo + (size_t)l * 256 * 1024, 1024, 256, 1024, wb + WB_MO, 0, 0, rot, nullptr); rot += 32;
        convert_weight(lds, P.w_gu + (size_t)l * 1024 * 5632, 5632, 1024, 5632, wb + WB_GU, 2, 0, rot, P.norm_ffn + l * 1024); rot += 704;
        convert_weight(lds, P.w_down + (size_t)l * 2816 * 1024, 1024, 2816, 1024, wb + WB_DOWN, 0, 0, rot, nullptr); rot += 352;
        norm_rows(P.mem, P.norm_mem + l * 1024, (bf16_t*)(P.ws + OFF_MEMN) + (size_t)l * 512 * 1024, BATCH * MEM_LEN);
    }
    xb_rows(P.x, (bf16_t*)(P.ws + OFF_XN), (float*)(P.ws + OFF_PART), NTOK);
    float* cs = (float*)(P.ws + OFF_CS);
    for (int i = blockIdx.x * NTHREADS + opaque_tid(); i < NTOK * 8; i += gridDim.x * NTHREADS) {
        const int tok = i >> 3, f = i & 7;
        const float invf = (f == 0) ? 1.0f : (f == 1) ? 0.19392547244381735f : (f == 2) ? 0.037606030930863934f : (f == 3) ? 0.007292767314834156f :
                           (f == 4) ? 0.0014142135623730951f : (f == 5) ? 0.0002742520333386866f : (f == 6) ? 5.318295896944989e-05f : 1.0313530666425395e-05f;
        const float ang = (float)P.pos[tok] * invf;
        cs[2 * i] = cosf(ang); cs[2 * i + 1] = sinf(ang);
    }
}

__global__ void __launch_bounds__(NTHREADS, 2) fwd_megakernel(Params P) {
    extern __shared__ __attribute__((aligned(16))) unsigned char lds[];
    cg::grid_group grid = cg::this_grid();
    unsigned* ctrl = (unsigned*)(P.ws + OFF_CTRL);
    bf16_t* XN = (bf16_t*)(P.ws + OFF_XN);
    if (blockIdx.x == 0 && threadIdx.x < 8) {
        const int l = threadIdx.x >> 2, ty = threadIdx.x & 3, n = ty == 0 ? 32 : 64;
        const float* gq = ty == 0 ? P.qn_diff + l * 32 : ty == 1 ? P.qn_moba + l * 64 : ty == 2 ? P.qn_dil + l * 64 : P.qn_mem + l * 64;
        const float* gk = ty == 0 ? P.kn_diff + l * 32 : ty == 1 ? P.kn_moba + l * 64 : ty == 2 ? P.kn_dil + l * 64 : P.kn_mem + l * 64;
        float a = 0.f, b = 0.f;
        for (int i = 0; i < n; ++i) { a = fmaxf(a, fabsf(gq[i])); b = fmaxf(b, fabsf(gk[i])); }
        ((float*)(P.ws + OFF_SB))[threadIdx.x] = a * b * (float)n * (ty == 0 ? 0.17677669529663687f : 0.125f) * 1.4426950408889634f * 1.02f;
    }
    if (blockIdx.x == 0) {
        float* gt = (float*)(P.ws + OFF_GT);
        for (int i = threadIdx.x; i < 768; i += NTHREADS) {
            const int d = i & 63, ty = (i >> 6) % 3, wh = (i / 192) & 1, l = i / 384;
            float v = 0.f;
            if (ty == 0) { if (d < 32) v = (wh == 0 ? P.qn_diff : P.kn_diff)[l * 32 + d]; }
            else if (ty == 1) v = (wh == 0 ? P.qn_dil : P.kn_dil)[l * 64 + d];
            else v = (wh == 0 ? P.qn_moba : P.kn_moba)[l * 64 + d];
            gt[i] = v;
        }
    }
    volatile LAS unsigned* xbst = (volatile LAS unsigned*)((LAS unsigned char*)lds + 131072 + 64);
    if (threadIdx.x < 4) xbst[threadIdx.x] = 0u;
    __syncthreads();
    { XcdBarrier xb0 = xcd_barrier_post((unsigned*)(P.ws + OFF_BAR), xbst); if (threadIdx.x == 0) xbst[2] = xb0.x; }
    __syncthreads();
    prologue_phase(P, lds);
    if (P.ws == nullptr) grid.sync();
    xcd_barrier_at(P.ws, xbst);
    const float* PART = (const float*)(P.ws + OFF_PART);
    PG8_LAS unsigned char* glds = (PG8_LAS unsigned char*)lds;
    const int G = (int)gridDim.x, bx = (int)blockIdx.x;
    for (int l = 0; l < DEPTH; ++l) {
        const float* xin = (l == 0) ? P.x : P.out;
        const bf16_t* wb = (const bf16_t*)(P.ws + OFF_WB) + (size_t)l * WB_LAYER;
        {
            pg8::Gemm g{XN, wb + WB_IN, NTOK, 2048, 1024}; pg8::StaticOrder S; S.init(NTOK, 2048, G, bx);
            pg8::EpiQK e{(const float*)(P.ws + OFF_GT) + l * 384, (const float*)(P.ws + OFF_CS), (bf16_t*)(P.ws + OFF_Q), PART};
            pg8::gemm_phase<pg8::EpiQK, pg8::StaticOrder, true, true>(glds, g, S, e);
            pg8::Gemm g2{wb + WB_IN + (size_t)2048 * 1024, XN, 1024, NTOK, 1024}; pg8::StaticOrder S2; S2.init(1024, NTOK, G, bx);
            pg8::EpiVT e2{(bf16_t*)(P.ws + OFF_V), PART};
            pg8::gemm_phase<pg8::EpiVT, pg8::StaticOrder, true, true>(glds, g2, S2, e2);
        }
        xcd_barrier_at(P.ws, xbst);
        kmean_phase(P, lds);
        dil01_phase(P, lds, l);
        xcd_barrier_at(P.ws, xbst);
        attn_phase(P, lds, l, ctrl + 16 * l);
        xcd_barrier_at(P.ws, xbst);
        {
            pg8::Gemm g{(const bf16_t*)(P.ws + OFF_MIX), wb + WB_OUT, NTOK, 1024, 1024}; pg8::StaticOrder S; S.init(NTOK, 1024, G, bx);
            pg8::EpiResid2 e{xin, P.out, XN, (float*)(P.ws + OFF_PART)};
            pg8::gemm_phase<pg8::EpiResid2, pg8::StaticOrder, true, true>(glds, g, S, e);
        }
        xcd_barrier_at(P.ws, xbst);
        {
            pg8::Gemm g{XN, wb + WB_MQ, NTOK, 256, 1024}; pg8::StaticOrder S; S.init(NTOK, 256, G, bx);
            pg8::EpiHead2 e{P.qn_mem + l * 64, (bf16_t*)(P.ws + OFF_QM), nullptr, PART};
            pg8::gemm_phase<pg8::EpiHead2, pg8::StaticOrder, true, true>(glds, g, S, e);
            pg8::Gemm g2{(const bf16_t*)(P.ws + OFF_MEMN) + (size_t)l * 512 * 1024, wb + WB_MKV, 512, 512, 1024}; pg8::StaticOrder S2; S2.init(512, 512, G, (bx + G - 64) % G);
            pg8::EpiHead2 e2{P.kn_mem + l * 64, (bf16_t*)(P.ws + OFF_KMEM), (bf16_t*)(P.ws + OFF_VMEM), nullptr};
            pg8::gemm_phase<pg8::EpiHead2, pg8::StaticOrder, true, true>(glds, g2, S2, e2);
        }
        xcd_barrier_at(P.ws, xbst);
        xattn_block_phase(P, lds, l);
        xcd_barrier_at(P.ws, xbst);
        {
            pg8::Gemm g{(const bf16_t*)(P.ws + OFF_OM), wb + WB_MO, NTOK, 1024, 256}; pg8::StaticOrder S; S.init(NTOK, 1024, G, bx);
            pg8::EpiResid2 e{P.out, P.out, XN, (float*)(P.ws + OFF_PART)};
            pg8::gemm_phase<pg8::EpiResid2, pg8::StaticOrder, true, true>(glds, g, S, e);
        }
        xcd_barrier_at(P.ws, xbst);
        {
            pg8::Gemm g{XN, wb + WB_GU, NTOK, 2 * D_FF, 1024}; pg8::StaticOrder S; S.init(NTOK, 2 * D_FF, G, bx);
            pg8::EpiSwiglu2 e{(bf16_t*)(P.ws + OFF_H), PART};
            pg8::gemm_phase<pg8::EpiSwiglu2, pg8::StaticOrder, true, true>(glds, g, S, e);
        }
        xcd_barrier_at(P.ws, xbst);
        {
            pg8::Gemm g{(const bf16_t*)(P.ws + OFF_H), wb + WB_DOWN, NTOK, 1024, D_FF}; pg8::StaticOrder S; S.init(NTOK, 1024, G, bx);
            pg8::EpiResid2 e{P.out, P.out, (l + 1 < DEPTH) ? XN : nullptr, (float*)(P.ws + OFF_PART)};
            pg8::gemm_phase<pg8::EpiResid2, pg8::StaticOrder, true, true>(glds, g, S, e);
        }
        if (l + 1 < DEPTH) xcd_barrier_at(P.ws, xbst);
    }
}

extern "C" void kernel_launch(void* const* d_in, const int* in_sizes, int n_in, void* d_out, int out_size, void* d_ws, size_t ws_size, hipStream_t stream) {
    static int grid_blocks = 0;
    if (!grid_blocks) {
        int dev = 0, cus = 0, per_cu = 0;
        hipGetDevice(&dev);
        hipDeviceGetAttribute(&cus, hipDeviceAttributeMultiprocessorCount, dev);
        hipFuncSetAttribute((const void*)fwd_megakernel, hipFuncAttributeMaxDynamicSharedMemorySize, LDS_BYTES);
        hipOccupancyMaxActiveBlocksPerMultiprocessor(&per_cu, fwd_megakernel, NTHREADS, LDS_BYTES);
        if (per_cu < 1) per_cu = 1;
        if (per_cu > 1) per_cu = 1;
        grid_blocks = cus * per_cu;
    }
    Params p{};
    p.x = (const float*)d_in[0]; p.mem = (const float*)d_in[1]; p.pos = (const int*)d_in[2];
    p.norm_mix = (const float*)d_in[3]; p.w_in = (const float*)d_in[4]; p.qn_diff = (const float*)d_in[5]; p.kn_diff = (const float*)d_in[6];
    p.lq1 = (const float*)d_in[7]; p.lk1 = (const float*)d_in[8]; p.lq2 = (const float*)d_in[9]; p.lk2 = (const float*)d_in[10]; p.subln = (const float*)d_in[11];
    p.qn_dil = (const float*)d_in[12]; p.kn_dil = (const float*)d_in[13]; p.qn_moba = (const float*)d_in[14]; p.kn_moba = (const float*)d_in[15]; p.w_out = (const float*)d_in[16];
    p.norm_cross = (const float*)d_in[17]; p.norm_mem = (const float*)d_in[18]; p.w_mq = (const float*)d_in[19]; p.w_mkv = (const float*)d_in[20];
    p.qn_mem = (const float*)d_in[21]; p.kn_mem = (const float*)d_in[22]; p.w_mo = (const float*)d_in[23]; p.norm_ffn = (const float*)d_in[24];
    p.w_gu = (const float*)d_in[25]; p.w_down = (const float*)d_in[26];
    p.out = (float*)d_out; p.ws = (unsigned char*)d_ws;
    hipMemsetAsync(d_ws, 0, 32768, stream);
    void* args[] = {&p};
    hipError_t e = hipLaunchCooperativeKernel((const void*)fwd_megakernel, dim3(grid_blocks), dim3(NTHREADS), args, LDS_BYTES, stream);
    if (e != hipSuccess) fprintf(stderr, "cooperative launch failed: %s (grid %d)\n", hipGetErrorString(e), grid_blocks);
}
```
